# Optimizing an MI355X kernel written in HIP

```python
import jax, jax.numpy as jnp
from jax import lax
import numpy as np


D_MODEL = 2048
BATCH = 4
SEQ = 2048
DEPTH = 2

HEAD_DIM = 128
ROPE_THETA = 10000.0
NORM_EPS = 1e-6
Q_BLOCK = 128
NEG = -1e30

NSA_HEADS = D_MODEL // (2 * HEAD_DIM)
NSA_KV_GROUPS = 2
CMP_LEN = 32
CMP_STRIDE = 16
CMP_HIDDEN = 256
SLC_LEN = 64
SLC_TOP = 8
WIN = 512
FOX_HEADS = D_MODEL // (2 * HEAD_DIM)
MLA_HEADS = D_MODEL // HEAD_DIM
MLA_Q_RANK = 512
MLA_KV_RANK = 512
MLA_NOPE = 128
MLA_ROPE = 64
MLA_V = 128
D_FF = 5632

NSA_Q = NSA_HEADS * HEAD_DIM
NSA_KV = NSA_KV_GROUPS * HEAD_DIM
FOX_W = FOX_HEADS * HEAD_DIM
HYB_SPLITS = (NSA_Q, NSA_KV, NSA_KV, NSA_KV, NSA_KV, NSA_KV, NSA_KV, 3 * NSA_HEADS, FOX_W, FOX_W, FOX_W, FOX_HEADS)
HYB_IN = sum(HYB_SPLITS)
HYB_OUT = NSA_Q + FOX_W
MLA_SPLITS = (MLA_Q_RANK, MLA_KV_RANK, MLA_ROPE)
MLA_IN = sum(MLA_SPLITS)
N_EVEN = (DEPTH + 1) // 2
N_ODD = DEPTH // 2

kernel_name = 'hybrid_nsa_fox_mla_macaron'


def split_cols(a, sizes):
    out, start = [], 0
    for s in sizes:
        out.append(a[..., start:start + s])
        start += s
    return out


def rms_norm(x, g):
    x32 = x.astype(jnp.float32)
    y = x32 * lax.rsqrt(jnp.mean(x32 * x32, axis=-1, keepdims=True) + NORM_EPS)
    return (y * g.astype(jnp.float32)).astype(x.dtype)


def rope(x, pos):
    d = x.shape[-1]
    inv = 1.0 / (ROPE_THETA ** (np.arange(0, d, 2, dtype=np.float32) / d))
    ang = pos.astype(jnp.float32)[:, None] * jnp.asarray(inv, jnp.float32)[None, :]
    cos = jnp.cos(ang)[None, :, None, :]
    sin = jnp.sin(ang)[None, :, None, :]
    x32 = x.astype(jnp.float32)
    x1, x2 = x32[..., : d // 2], x32[..., d // 2:]
    return jnp.concatenate([x1 * cos - x2 * sin, x2 * cos + x1 * sin], axis=-1).astype(x.dtype)


def swiglu(x, w_in, w_out):
    h = x @ w_in
    return (jax.nn.silu(h[..., :D_FF]) * h[..., D_FF:]) @ w_out


def to_chunks(a):
    b, t = a.shape[:2]
    return jnp.moveaxis(a.reshape(b, t // Q_BLOCK, Q_BLOCK, *a.shape[2:]), 1, 0)


def from_chunks(a):
    a = jnp.moveaxis(a, 0, 1)
    return a.reshape(a.shape[0], -1, *a.shape[3:])


def blocked_causal_attention(q, k, v, scale, cum_log_f=None):
    t_len = q.shape[1]
    kpos = jnp.arange(t_len)
    xs = [to_chunks(q), jnp.arange(t_len).reshape(-1, Q_BLOCK)]
    ck = None
    if cum_log_f is not None:
        xs.append(to_chunks(cum_log_f))
        ck = jnp.moveaxis(cum_log_f, 1, 2)[:, :, None, :]

    def block(args):
        qc, qpos = args[0], args[1]
        s = jnp.einsum('bqhd,bkhd->bhqk', qc, k).astype(jnp.float32) * scale
        if ck is not None:
            s = s + (jnp.moveaxis(args[2], 1, 2)[..., None] - ck)
        s = jnp.where(kpos[None, :] <= qpos[:, None], s, NEG)
        p = jax.nn.softmax(s, axis=-1)
        return jnp.einsum('bhqk,bkhd->bqhd', p.astype(v.dtype), v)

    return from_chunks(lax.map(block, tuple(xs)))


def cmp_to_slc_matrix(n_cmp, n_slc):
    c0 = np.arange(n_cmp) * CMP_STRIDE
    c1 = c0 + CMP_LEN
    s0 = np.arange(n_slc) * SLC_LEN
    s1 = s0 + SLC_LEN
    ov = np.clip(np.minimum(c1[:, None], s1[None, :]) - np.maximum(c0[:, None], s0[None, :]), 0, None)
    return (ov / CMP_LEN).astype(np.float32)


def nsa_attention(q, k_cmp, v_cmp, k_slc, v_slc, k_win, v_win, gates, pos, cmp_pe, cmp_w1, cmp_w2):
    b, t_len, h, d = q.shape
    g = k_cmp.shape[2]
    hg = h // g
    scale = d ** -0.5
    q_plain = q.reshape(b, t_len, g, hg, d)
    q_rot = rope(q, pos).reshape(b, t_len, g, hg, d)
    k_slc = rope(k_slc, pos)
    k_win = rope(k_win, pos)

    n_cmp = (t_len - CMP_LEN) // CMP_STRIDE + 1
    blk = np.arange(n_cmp)[:, None] * CMP_STRIDE + np.arange(CMP_LEN)[None, :]

    def compress(x, pe, w1, w2):
        xb = x[:, blk] + pe[None, None, :, None, :]
        xb = jnp.moveaxis(xb, 3, 2).reshape(b, n_cmp, g, CMP_LEN * d)
        return jax.nn.gelu(xb @ w1) @ w2

    kc = compress(k_cmp, cmp_pe[0], cmp_w1[0], cmp_w2[0])
    vc = compress(v_cmp, cmp_pe[1], cmp_w1[1], cmp_w2[1])
    cmp_end = jnp.asarray(np.arange(n_cmp) * CMP_STRIDE + CMP_LEN - 1)
    cmask = cmp_end[None, :] <= pos[:, None]
    s = jnp.einsum('btghd,bngd->bghtn', q_plain, kc).astype(jnp.float32) * scale
    p_cmp = jax.nn.softmax(jnp.where(cmask, s, NEG), axis=-1) * cmask
    o_cmp = jnp.einsum('bghtn,bngd->btghd', p_cmp.astype(vc.dtype), vc)

    n_slc = t_len // SLC_LEN
    top = min(SLC_TOP, n_slc)
    imp = jnp.einsum('bghtn,nj->btgj', p_cmp, jnp.asarray(cmp_to_slc_matrix(n_cmp, n_slc)))
    j = jnp.arange(n_slc)[None, None, :]
    cur = (pos // SLC_LEN)[:, None, None]
    forced = (j == 0) | (j == cur) | (j == cur - 1)
    imp = jnp.where(j > cur, -jnp.inf, jnp.where(forced, jnp.inf, imp))
    _, sel = lax.top_k(imp, top)
    kblk = jnp.moveaxis(k_slc.reshape(b, n_slc, SLC_LEN, g, d), 3, 1)
    vblk = jnp.moveaxis(v_slc.reshape(b, n_slc, SLC_LEN, g, d), 3, 1)
    bi = jnp.arange(b)[:, None, None, None]
    gi = jnp.arange(g)[None, None, :, None]
    offs = jnp.arange(SLC_LEN)

    def slc_block(args):
        qc, sc, qpos = args
        kg = kblk[bi, gi, sc]
        vg = vblk[bi, gi, sc]
        kpos = sc[..., None] * SLC_LEN + offs
        m = (kpos <= qpos[None, :, None, None, None])[:, :, :, None]
        s = jnp.einsum('bqghd,bqgkld->bqghkl', qc, kg).astype(jnp.float32) * scale
        s = jnp.where(m, s, NEG)
        bq = qc.shape[1]
        p = jax.nn.softmax(s.reshape(b, bq, g, hg, top * SLC_LEN), axis=-1)
        p = p.reshape(b, bq, g, hg, top, SLC_LEN)
        return jnp.einsum('bqghkl,bqgkld->bqghd', p.astype(vg.dtype), vg)

    o_slc = from_chunks(lax.map(slc_block, (to_chunks(q_rot), to_chunks(sel), pos.reshape(-1, Q_BLOCK))))

    nc = t_len // Q_BLOCK
    band = np.arange(nc)[:, None] * Q_BLOCK + np.arange(WIN + Q_BLOCK)[None, :]
    pad = ((0, 0), (WIN, 0), (0, 0), (0, 0))
    kb = jnp.pad(k_win, pad)[:, band]
    vb = jnp.pad(v_win, pad)[:, band]
    qq = np.arange(Q_BLOCK)[:, None]
    kk = np.arange(WIN + Q_BLOCK)[None, :]
    wmask = ((kk > qq) & (kk <= qq + WIN))[None] & ((np.arange(nc)[:, None, None] * Q_BLOCK + kk[None]) >= WIN)
    qw = q_rot.reshape(b, nc, Q_BLOCK, g, hg, d)
    s = jnp.einsum('bcqghd,bckgd->bcghqk', qw, kb).astype(jnp.float32) * scale
    s = jnp.where(jnp.asarray(wmask)[None, :, None, None], s, NEG)
    p = jax.nn.softmax(s, axis=-1)
    o_win = jnp.einsum('bcghqk,bckgd->bcqghd', p.astype(vb.dtype), vb).reshape(b, t_len, g, hg, d)

    gt = gates.reshape(b, t_len, g, hg, 3)
    return o_cmp * gt[..., 0:1] + o_slc * gt[..., 1:2] + o_win * gt[..., 2:3]


def hybrid_mixer(h, w_in, w_out, cmp_pe, cmp_w1, cmp_w2, f_bias):
    b, t_len, _ = h.shape
    pos = jnp.arange(t_len)
    (q_n, k_c, v_c, k_s, v_s, k_w, v_w, g_logit,
     q_f, k_f, v_f, f_logit) = split_cols(h @ w_in, HYB_SPLITS)
    heads = lambda a, n: a.reshape(b, t_len, n, HEAD_DIM)
    gates = jax.nn.sigmoid(g_logit.astype(jnp.float32)).reshape(b, t_len, NSA_HEADS, 3).astype(h.dtype)
    o_nsa = nsa_attention(heads(q_n, NSA_HEADS),
                          heads(k_c, NSA_KV_GROUPS), heads(v_c, NSA_KV_GROUPS),
                          heads(k_s, NSA_KV_GROUPS), heads(v_s, NSA_KV_GROUPS),
                          heads(k_w, NSA_KV_GROUPS), heads(v_w, NSA_KV_GROUPS),
                          gates, pos, cmp_pe, cmp_w1, cmp_w2)
    log_f = jax.nn.log_sigmoid(f_logit.astype(jnp.float32) + f_bias.astype(jnp.float32))
    cum = jnp.cumsum(log_f, axis=1)
    o_fox = blocked_causal_attention(heads(q_f, FOX_HEADS), heads(k_f, FOX_HEADS),
                                     heads(v_f, FOX_HEADS), HEAD_DIM ** -0.5, cum)
    o = jnp.concatenate([o_nsa.reshape(b, t_len, NSA_Q), o_fox.reshape(b, t_len, FOX_W)], axis=-1)
    return o @ w_out


def mla_mixer(h, w_in, q_norm, kv_norm, w_uq, w_ukv, w_out):
    b, t_len, _ = h.shape
    pos = jnp.arange(t_len)
    c_q, c_kv, k_r = split_cols(h @ w_in, MLA_SPLITS)
    q = (rms_norm(c_q, q_norm) @ w_uq).reshape(b, t_len, MLA_HEADS, MLA_NOPE + MLA_ROPE)
    q = jnp.concatenate([q[..., :MLA_NOPE], rope(q[..., MLA_NOPE:], pos)], axis=-1)
    kv = (rms_norm(c_kv, kv_norm) @ w_ukv).reshape(b, t_len, MLA_HEADS, MLA_NOPE + MLA_V)
    k_r = rope(k_r[:, :, None, :], pos)
    k = jnp.concatenate([kv[..., :MLA_NOPE], jnp.broadcast_to(k_r, (b, t_len, MLA_HEADS, MLA_ROPE))], axis=-1)
    o = blocked_causal_attention(q, k, kv[..., MLA_NOPE:], (MLA_NOPE + MLA_ROPE) ** -0.5)
    return o.reshape(b, t_len, MLA_HEADS * MLA_V) @ w_out


def setup_inputs(seed: int = 0) -> dict:
    key = jax.random.key(seed)
    ks = jax.random.split(key, 21)
    f32 = jnp.float32

    def w(k, shape, fan_in):
        return jax.random.normal(k, shape, f32) * (fan_in ** -0.5)

    def gain(k, shape):
        return 1.0 + 0.02 * jax.random.normal(k, shape, f32)

    return {
        'x': jax.random.normal(ks[0], (BATCH, SEQ, D_MODEL), f32),
        'ffn1_norm': gain(ks[1], (DEPTH, D_MODEL)),
        'ffn1_w_in': w(ks[2], (DEPTH, D_MODEL, 2 * D_FF), D_MODEL),
        'ffn1_w_out': w(ks[3], (DEPTH, D_FF, D_MODEL), D_FF),
        'mix_norm': gain(ks[4], (DEPTH, D_MODEL)),
        'ffn2_norm': gain(ks[5], (DEPTH, D_MODEL)),
        'ffn2_w_in': w(ks[6], (DEPTH, D_MODEL, 2 * D_FF), D_MODEL),
        'ffn2_w_out': w(ks[7], (DEPTH, D_FF, D_MODEL), D_FF),
        'hyb_w_in': w(ks[8], (N_EVEN, D_MODEL, HYB_IN), D_MODEL),
        'hyb_w_out': w(ks[9], (N_EVEN, HYB_OUT, D_MODEL), HYB_OUT),
        'nsa_cmp_pe': 0.02 * jax.random.normal(ks[10], (N_EVEN, 2, CMP_LEN, HEAD_DIM), f32),
        'nsa_cmp_w1': w(ks[11], (N_EVEN, 2, CMP_LEN * HEAD_DIM, CMP_HIDDEN), CMP_LEN * HEAD_DIM),
        'nsa_cmp_w2': w(ks[12], (N_EVEN, 2, CMP_HIDDEN, HEAD_DIM), CMP_HIDDEN),
        'fox_f_bias': jax.random.uniform(ks[13], (N_EVEN, FOX_HEADS), f32, 1.0, 4.0),
        'mla_w_in': w(ks[14], (N_ODD, D_MODEL, MLA_IN), D_MODEL),
        'mla_q_norm': gain(ks[15], (N_ODD, MLA_Q_RANK)),
        'mla_kv_norm': gain(ks[16], (N_ODD, MLA_KV_RANK)),
        'mla_w_uq': w(ks[17], (N_ODD, MLA_Q_RANK, MLA_HEADS * (MLA_NOPE + MLA_ROPE)), MLA_Q_RANK),
        'mla_w_ukv': w(ks[18], (N_ODD, MLA_KV_RANK, MLA_HEADS * (MLA_NOPE + MLA_V)), MLA_KV_RANK),
        'mla_w_out': w(ks[19], (N_ODD, MLA_HEADS * MLA_V, D_MODEL), MLA_HEADS * MLA_V),
        'final_norm': gain(ks[20], (D_MODEL,)),
    }


def reference(x, ffn1_norm, ffn1_w_in, ffn1_w_out, mix_norm, ffn2_norm, ffn2_w_in, ffn2_w_out,
              hyb_w_in, hyb_w_out, nsa_cmp_pe, nsa_cmp_w1, nsa_cmp_w2, fox_f_bias,
              mla_w_in, mla_q_norm, mla_kv_norm, mla_w_uq, mla_w_ukv, mla_w_out, final_norm):
    for i in range(DEPTH):
        x = x + 0.5 * swiglu(rms_norm(x, ffn1_norm[i]), ffn1_w_in[i], ffn1_w_out[i])
        h = rms_norm(x, mix_norm[i])
        if i % 2 == 0:
            e = i // 2
            x = x + hybrid_mixer(h, hyb_w_in[e], hyb_w_out[e], nsa_cmp_pe[e], nsa_cmp_w1[e],
                                 nsa_cmp_w2[e], fox_f_bias[e])
        else:
            o = i // 2
            x = x + mla_mixer(h, mla_w_in[o], mla_q_norm[o], mla_kv_norm[o], mla_w_uq[o],
                              mla_w_ukv[o], mla_w_out[o])
        x = x + 0.5 * swiglu(rms_norm(x, ffn2_norm[i]), ffn2_w_in[i], ffn2_w_out[i])
    return rms_norm(x, final_norm)
```

```cpp
#include <hip/hip_runtime.h>
#include <hip/hip_cooperative_groups.h>
#include <cstdio>
#include <cstdint>
namespace cg = cooperative_groups;
#ifndef PROBE_SYNC2
#define PROBE_SYNC2 0
#endif
#ifndef PROBE_UPX2
#define PROBE_UPX2 0
#endif
#ifndef PROBE_ATTX2
#define PROBE_ATTX2 0
#endif
#ifndef PROBE_P0X2
#define PROBE_P0X2 0
#endif
#define GSYNC() do { xcd_barrier(xbar); if (PROBE_SYNC2) xcd_barrier(xbar); } while (0)
namespace pg8 {
#define PG8_LAS __attribute__((address_space(3)))
typedef unsigned short bf16_t;
typedef short bf16x8 __attribute__((ext_vector_type(8)));
typedef float f32x4 __attribute__((ext_vector_type(4)));
typedef unsigned u32x4 __attribute__((ext_vector_type(4)));
constexpr int BM = 256, BK = 64, HALF = 128, HTB = HALF * BK * 2  , STAGE_BYTES = 8 * HTB, NXCD = 8, WGM = 8;

__host__ __device__ __forceinline__ int lds_byte(int r, int c) { const int st = (r >> 4) * 2 + (c >> 5), rr = r & 15, cc = c & 31, ob = rr * 64 + cc * 2; return st * 1024 + (ob ^ (((ob >> 9) & 1) << 5)); }
__host__ __device__ __forceinline__ void stage_rc(int b, int& R, int& C) { const int st = b / 1024, sb = b % 1024, swz = sb ^ (((sb >> 9) & 1) << 5); R = (st >> 1) * 16 + swz / 64; C = (st & 1) * 32 + (swz % 64) / 2; }
__host__ __device__ __forceinline__ int perm32(int rho) { const int n = rho >> 4, i = rho & 15; return 8 * (i >> 2) + 4 * n + (i & 3); }

struct Unit { int pm, pn; };

struct StaticOrder {
    int nM, nN, nwg, G, c;
    __host__ __device__ void init(int M, int N, int G_, int c_) { nM = M / BM; nN = N / BM; nwg = nM * nN; G = G_; c = c_; }
    __host__ __device__ bool next(int i, Unit& u) const {
        const long L = (long)i * G + c; if (L >= nwg) return false;
        int wgid = (int)L; { const int q = nwg / NXCD, r = nwg % NXCD, xcd = wgid % NXCD, off = wgid / NXCD; wgid = (xcd < r ? xcd * (q + 1) : r * (q + 1) + (xcd - r) * q) + off; }
        const int nig = WGM * nN, gid = wgid / nig, fm = gid * WGM, gsz = (nM - fm) < WGM ? (nM - fm) : WGM;
        u.pm = fm + ((wgid % nig) % gsz); u.pn = (wgid % nig) / gsz; return true;
    }
    __device__ __forceinline__ void a_ready(const Unit&) const {}
    __device__ __forceinline__ void done(const Unit&) const {}
};

struct Gemm { const bf16_t* A; const bf16_t* A2; const bf16_t* Bt; int M, N, K, lda, pn2; };
struct ListOrder {
    int nM, nwg, G, c;
    __device__ void init(int M, int N, int G_, int c_) { nM = M / BM; nwg = nM * (N / BM); G = G_; c = c_; }
    __device__ bool next(int i, Unit& u) const { const long L = (long)i * G + c; if (L >= nwg) return false; u.pm = (int)L % nM; u.pn = (int)L / nM; return true; }
    __device__ __forceinline__ void a_ready(const Unit&) const {}
    __device__ __forceinline__ void done(const Unit&) const {}
};
typedef __bf16 bf16x2v __attribute__((ext_vector_type(2)));
typedef float f32x2v __attribute__((ext_vector_type(2)));
typedef unsigned u32x2 __attribute__((ext_vector_type(2)));
__device__ __forceinline__ unsigned pk_bf16(float lo, float hi) { f32x2v f = {lo, hi}; return __builtin_bit_cast(unsigned, __builtin_convertvector(f, bf16x2v)); }
__device__ __forceinline__ float bf_lo(unsigned u) { return __uint_as_float(u << 16); }
__device__ __forceinline__ float bf_hi(unsigned u) { return __uint_as_float(u & 0xffff0000u); }
__device__ __forceinline__ float bf2f(bf16_t v) { return __uint_as_float(((unsigned)v) << 16); }

constexpr float NORM_EPS = 1e-6f;
template <int PER> __device__ __forceinline__ float row_rstd(const float* ssq, int off, float invn, int row, int fq) {
    const float* p = ssq + (size_t)row * 32 + off + fq * PER; float s = 0.f;
#pragma unroll
    for (int i = 0; i < PER; ++i) s += p[i];
    s += __shfl_xor(s, 16); s += __shfl_xor(s, 32);
    return rsqrtf(s * invn + NORM_EPS);
}
__device__ __forceinline__ float silu_f(float g) { return g * __builtin_amdgcn_rcpf(1.f + __expf(-g)); }
__device__ __forceinline__ float gelu_tanh_f(float x) { const float u = 0.7978845608028654f * (x + 0.044715f * x * x * x); const float e = __expf(2.f * u); const float th = 1.f - 2.f * __builtin_amdgcn_rcpf(1.f + e); return 0.5f * x * (1.f + th); }

struct EpiSwiglu {
    static constexpr bool PERM = true, AFTER_DRAIN = false;
    bf16_t* O; int ldc; const float* ssq;
    __device__ __forceinline__ void operator()(const f32x4 (&acc)[2][2][4][2], const Unit& u, int wr, int wc, int fr, int fq) const {
        const int row0 = u.pm * BM + wr * 64 + fr, col0 = u.pn * 128 + wc * 32 + 8 * fq;
        float rsv[2][4];
#pragma unroll
        for (int ai = 0; ai < 2; ++ai)
#pragma unroll
            for (int m = 0; m < 4; ++m) rsv[ai][m] = row_rstd<8>(ssq, 0, 1.f / 2048.f, row0 + ai * HALF + m * 16, fq);
#pragma unroll
        for (int ai = 0; ai < 2; ++ai)
#pragma unroll
            for (int m = 0; m < 4; ++m) {
                const int row = row0 + ai * HALF + m * 16; const float rs = rsv[ai][m];
                f32x4 v0, v1;
#pragma unroll
                for (int j = 0; j < 4; ++j) { v0[j] = silu_f(acc[ai][0][m][0][j] * rs) * (acc[ai][1][m][0][j] * rs); v1[j] = silu_f(acc[ai][0][m][1][j] * rs) * (acc[ai][1][m][1][j] * rs); }
                u32x4 w; w.x = pk_bf16(v0[0], v0[1]); w.y = pk_bf16(v0[2], v0[3]); w.z = pk_bf16(v1[0], v1[1]); w.w = pk_bf16(v1[2], v1[3]);
                *(u32x4*)(O + (size_t)row * ldc + col0) = w;
            }
    }
};
template <int PER, bool SSQ_OUT> struct EpiScale {
    static constexpr bool PERM = true, AFTER_DRAIN = false;
    bf16_t* O; int ldc; bf16_t* O2; int ldc2; int pn2; const float* ssq; int soff, soff2; float invn; float* ssq_out;
    __device__ __forceinline__ void operator()(const f32x4 (&acc)[2][2][4][2], const Unit& u, int wr, int wc, int fr, int fq) const {
        const int row0 = u.pm * BM + wr * 64 + fr; const bool second = u.pn >= pn2;
        bf16_t* base = second ? O2 : O; const int ld = second ? ldc2 : ldc; const int so = second ? soff2 : soff;
        const int col0 = (second ? u.pn - pn2 : u.pn) * BM + wc * 32 + 8 * fq;
        float rsv[2][4];
#pragma unroll
        for (int ai = 0; ai < 2; ++ai)
#pragma unroll
            for (int m = 0; m < 4; ++m) rsv[ai][m] = row_rstd<PER>(ssq, so, invn, row0 + ai * HALF + m * 16, fq);
#pragma unroll
        for (int ai = 0; ai < 2; ++ai)
#pragma unroll
            for (int m = 0; m < 4; ++m) {
                const int row = row0 + ai * HALF + m * 16; const float rs = rsv[ai][m];
                float sq = 0.f;
#pragma unroll
                for (int bj = 0; bj < 2; ++bj) { const f32x4 v0 = acc[ai][bj][m][0] * rs, v1 = acc[ai][bj][m][1] * rs;
                    if (SSQ_OUT) sq += (v0[0] * v0[0] + v0[1] * v0[1]) + (v0[2] * v0[2] + v0[3] * v0[3]) + (v1[0] * v1[0] + v1[1] * v1[1]) + (v1[2] * v1[2] + v1[3] * v1[3]);
                    u32x4 w; w.x = pk_bf16(v0[0], v0[1]); w.y = pk_bf16(v0[2], v0[3]); w.z = pk_bf16(v1[0], v1[1]); w.w = pk_bf16(v1[2], v1[3]);
                    *(u32x4*)(base + (size_t)row * ld + col0 + bj * HALF) = w; }
                if (SSQ_OUT) { sq += __shfl_xor(sq, 16); sq += __shfl_xor(sq, 32); if (fq == 0) ssq_out[(size_t)row * 32 + u.pn * 4 + wc] = sq; }
            }
    }
};
struct EpiResid {
    static constexpr bool PERM = false, AFTER_DRAIN = false;
    const float* base; float* out; bf16_t* xb; float* ssq; float c;
    __device__ __forceinline__ void operator()(const f32x4 (&acc)[2][2][4][2], const Unit& u, int wr, int wc, int fr, int fq) const {
        const int row0 = u.pm * BM + wr * 64 + fr, col0 = u.pn * BM + wc * 32 + 4 * fq;
        f32x4 bv[8][2][2];
#define RES_LD(g) do { const size_t ro_ = (size_t)(row0 + ((g) >> 2) * HALF + ((g) & 3) * 16) * 2048 + col0; \
        _Pragma("unroll") for (int bj = 0; bj < 2; ++bj) _Pragma("unroll") for (int n = 0; n < 2; ++n) bv[g][bj][n] = *(const f32x4*)(base + ro_ + bj * HALF + n * 16); } while (0)
        RES_LD(0); RES_LD(1); RES_LD(2);
#pragma unroll
        for (int g = 0; g < 8; ++g) {
            const int ai = g >> 2, m = g & 3; const int row = row0 + ai * HALF + m * 16; float sq = 0.f;
#pragma unroll
            for (int bj = 0; bj < 2; ++bj)
#pragma unroll
                for (int n = 0; n < 2; ++n) { const size_t off = (size_t)row * 2048 + col0 + bj * HALF + n * 16;
                    const f32x4 v = bv[g][bj][n] + acc[ai][bj][m][n] * c;
                    *(f32x4*)(out + off) = v; sq += (v[0] * v[0] + v[1] * v[1]) + (v[2] * v[2] + v[3] * v[3]);
                    u32x2 w; w.x = pk_bf16(v[0], v[1]); w.y = pk_bf16(v[2], v[3]); *(u32x2*)(xb + off) = w; }
            sq += __shfl_xor(sq, 16); sq += __shfl_xor(sq, 32); if (fq == 0) ssq[(size_t)row * 32 + u.pn * 4 + wc] = sq;
            if (g + 3 < 8) { switch (g + 3) { case 3: RES_LD(3); break; case 4: RES_LD(4); break; case 5: RES_LD(5); break; case 6: RES_LD(6); break; default: RES_LD(7); break; } }
        }
#undef RES_LD
    }
};
struct EpiGelu {
    static constexpr bool PERM = true, AFTER_DRAIN = false;
    bf16_t* HID; const float* bias;
    __device__ __forceinline__ void operator()(const f32x4 (&acc)[2][2][4][2], const Unit& u, int wr, int wc, int fr, int fq) const {
        const int row0 = u.pm * BM + wr * 64 + fr, col0 = wc * 32 + 8 * fq;
        f32x4 bb[2][2];
#pragma unroll
        for (int bj = 0; bj < 2; ++bj) { const float* bp = bias + u.pn * 256 + col0 + bj * HALF; bb[bj][0] = *(const f32x4*)bp; bb[bj][1] = *(const f32x4*)(bp + 4); }
#pragma unroll
        for (int ai = 0; ai < 2; ++ai)
#pragma unroll
            for (int m = 0; m < 4; ++m) { const int row = row0 + ai * HALF + m * 16;
#pragma unroll
                for (int bj = 0; bj < 2; ++bj) { float v[8];
#pragma unroll
                    for (int j = 0; j < 4; ++j) { v[j] = gelu_tanh_f(acc[ai][bj][m][0][j] + bb[bj][0][j]); v[4 + j] = gelu_tanh_f(acc[ai][bj][m][1][j] + bb[bj][1][j]); }
                    u32x4 w; w.x = pk_bf16(v[0], v[1]); w.y = pk_bf16(v[2], v[3]); w.z = pk_bf16(v[4], v[5]); w.w = pk_bf16(v[6], v[7]);
                    *(u32x4*)(HID + ((size_t)u.pn * 1024 + row) * 256 + col0 + bj * HALF) = w; } }
    }
};
template <class Epi, class Sched, bool ALIGN_EPI = false, bool SP2 = false>
__device__ __forceinline__ void gemm_phase(PG8_LAS unsigned char* lds, const Gemm g, const Sched& S, const Epi& E) {
    int tid_op = threadIdx.x; asm volatile("" : "+v"(tid_op));
    const int tid = tid_op, wid = __builtin_amdgcn_readfirstlane(tid >> 6), lane = tid & 63, wr = wid >> 2, wc = wid & 3, fr = lane & 15, fq = lane >> 4;
    const int K = g.K, nt = K / BK;
    unsigned voffA[2], voffB[2];
#pragma unroll
    for (int i = 0; i < 2; ++i) { int R, C; stage_rc(tid * 16 + i * 8192, R, C); const int Rb = Epi::PERM ? ((R & ~31) + perm32(R & 31)) : R;
        voffA[i] = (unsigned)(R * g.lda + C) * 2u; voffB[i] = (unsigned)(Rb * K + C) * 2u; }
    const size_t kstep = (size_t)(BK * 2);
    const size_t hstepB = (size_t)HALF * K * 2, hstepA = (size_t)HALF * g.lda * 2;
    const size_t tstepA = 2 * hstepA, tstepB = 2 * hstepB;
    const unsigned ldsw = (unsigned)wid * 1024u;
    const int aoff = lds_byte(wr * 64 + fr, fq * 8), boff = lds_byte(wc * 32 + fr, fq * 8);
#define PG8_SA(b, h) (((b) * 2 + (h)) * HTB)
#define PG8_SB(b, h) ((4 + (b) * 2 + (h)) * HTB)
#define PG8_STAGE(bufoff, gbase, voff) do { _Pragma("unroll") for (int _i = 0; _i < 2; ++_i) \
        __builtin_amdgcn_global_load_lds((const unsigned*)((const char*)(gbase) + (voff)[_i]), (PG8_LAS unsigned*)(lds + (bufoff) + ldsw + _i * 8192), 16, 0, 0); } while (0)
#define PG8_LDA(dst, b, h) do { _Pragma("unroll") for (int m = 0; m < 4; ++m) _Pragma("unroll") for (int k = 0; k < 2; ++k) dst[m][k] = *(const PG8_LAS bf16x8*)(lds + PG8_SA(b, h) + aoff + m * 2048 + k * 1024); } while (0)
#define PG8_LDB(dst, b, h) do { _Pragma("unroll") for (int n = 0; n < 2; ++n) _Pragma("unroll") for (int k = 0; k < 2; ++k) dst[n][k] = *(const PG8_LAS bf16x8*)(lds + PG8_SB(b, h) + boff + n * 2048 + k * 1024); } while (0)
#define PG8_MMA(ai, bj, At, Bt) do { __builtin_amdgcn_s_setprio(1); _Pragma("unroll") for (int m = 0; m < 4; ++m) _Pragma("unroll") for (int n = 0; n < 2; ++n) _Pragma("unroll") for (int k = 0; k < 2; ++k) \
        acc[ai][bj][m][n] = __builtin_amdgcn_mfma_f32_16x16x32_bf16(Bt[n][k], At[m][k], acc[ai][bj][m][n], 0, 0, 0); __builtin_amdgcn_s_setprio(0); } while (0)
#define PG8_WAIT_V(n) asm volatile("s_waitcnt vmcnt(" #n ")" ::: "memory")
#define PG8_WAIT_L(n) asm volatile("s_waitcnt lgkmcnt(" #n ")" ::: "memory")
#define PG8_BAR __builtin_amdgcn_s_barrier()
#define PG8_SCHED __builtin_amdgcn_sched_barrier(0)
    Unit cur, nxt; int ui = 0;
    if (!S.next(0, cur)) return;
    f32x4 acc[2][2][4][2];
#pragma unroll
    for (int a = 0; a < 2; ++a)
#pragma unroll
        for (int b = 0; b < 2; ++b)
#pragma unroll
            for (int m = 0; m < 4; ++m)
#pragma unroll
                for (int n = 0; n < 2; ++n) acc[a][b][m][n] = (f32x4){0.f, 0.f, 0.f, 0.f};
    bf16x8 At[4][2], B0[2][2], B1[2][2];
    const char* cA = (const char*)(cur.pn >= g.pn2 ? g.A2 : g.A) + (size_t)cur.pm * tstepA; const char* cB = (const char*)g.Bt + (size_t)cur.pn * tstepB;
    S.a_ready(cur);
    if constexpr (SP2) {
        PG8_STAGE(PG8_SB(0, 0), cB, voffB); PG8_STAGE(PG8_SB(0, 1), cB + hstepB, voffB); PG8_STAGE(PG8_SA(0, 0), cA, voffA); PG8_STAGE(PG8_SA(0, 1), cA + hstepA, voffA);
        if (wr == 1) PG8_BAR;
        PG8_WAIT_V(2); PG8_BAR;
        PG8_STAGE(PG8_SB(1, 0), cB + kstep, voffB); PG8_STAGE(PG8_SA(1, 0), cA + kstep, voffA); PG8_STAGE(PG8_SB(1, 1), cB + hstepB + kstep, voffB);
        PG8_WAIT_V(6); PG8_BAR;
    } else {
        PG8_STAGE(PG8_SB(0, 0), cB, voffB); PG8_STAGE(PG8_SA(0, 0), cA, voffA); PG8_STAGE(PG8_SB(0, 1), cB + hstepB, voffB); PG8_STAGE(PG8_SA(0, 1), cA + hstepA, voffA);
        if (wr == 1) PG8_BAR;
        PG8_WAIT_V(4); PG8_BAR;
        PG8_STAGE(PG8_SB(1, 0), cB + kstep, voffB); PG8_STAGE(PG8_SA(1, 0), cA + kstep, voffA); PG8_STAGE(PG8_SB(1, 1), cB + hstepB + kstep, voffB);
        PG8_WAIT_V(6); PG8_BAR;
    }
    for (;;) {
        const bool has_next = S.next(ui + 1, nxt);
        const char* nA = has_next ? (const char*)(nxt.pn >= g.pn2 ? g.A2 : g.A) + (size_t)nxt.pm * tstepA : cA; const char* nB = has_next ? (const char*)g.Bt + (size_t)nxt.pn * tstepB : cB;
        for (int t = 0; t < nt; t += 2) {
            const bool last = (t == nt - 2);
            const char* a1 = cA + (size_t)(t + 1) * kstep;
            const char* a2 = last ? nA : cA + (size_t)(t + 2) * kstep; const char* b2 = last ? nB : cB + (size_t)(t + 2) * kstep;
            const char* a3 = a2 + kstep; const char* b3 = b2 + kstep;
            if (last && has_next) S.a_ready(nxt);
            if constexpr (SP2) {
            PG8_LDB(B0, 0, 0); PG8_LDB(B1, 0, 1); PG8_SCHED; PG8_LDA(At, 0, 0); PG8_STAGE(PG8_SA(1, 1), a1 + hstepA, voffA);
            PG8_WAIT_V(8); PG8_WAIT_L(0); PG8_BAR; PG8_MMA(0, 0, At, B0); PG8_MMA(0, 1, At, B1); PG8_BAR; PG8_SCHED;
            PG8_LDA(At, 0, 1); PG8_STAGE(PG8_SB(0, 0), b2, voffB); PG8_STAGE(PG8_SB(0, 1), b2 + hstepB, voffB); PG8_STAGE(PG8_SA(0, 0), a2, voffA);
            PG8_WAIT_V(8); PG8_WAIT_L(0); PG8_BAR; PG8_MMA(1, 0, At, B0); PG8_MMA(1, 1, At, B1); PG8_BAR; PG8_SCHED;
            PG8_LDB(B0, 1, 0); PG8_LDB(B1, 1, 1); PG8_SCHED; PG8_LDA(At, 1, 0); PG8_STAGE(PG8_SA(0, 1), a2 + hstepA, voffA);
            PG8_WAIT_V(8); PG8_WAIT_L(0); PG8_BAR; PG8_MMA(0, 0, At, B0); PG8_MMA(0, 1, At, B1); PG8_BAR; PG8_SCHED;
            PG8_LDA(At, 1, 1); PG8_STAGE(PG8_SB(1, 0), b3, voffB); PG8_STAGE(PG8_SB(1, 1), b3 + hstepB, voffB); PG8_STAGE(PG8_SA(1, 0), a3, voffA);
            PG8_WAIT_V(8); PG8_WAIT_L(0); PG8_BAR; PG8_MMA(1, 0, At, B0); PG8_MMA(1, 1, At, B1); PG8_BAR; PG8_SCHED;
            } else {
            PG8_LDB(B0, 0, 0); PG8_SCHED; PG8_LDA(At, 0, 0); PG8_STAGE(PG8_SA(1, 1), a1 + hstepA, voffA);
            PG8_WAIT_L(8); PG8_BAR; PG8_WAIT_L(0); PG8_MMA(0, 0, At, B0); PG8_BAR; PG8_SCHED;
            PG8_LDB(B1, 0, 1); PG8_STAGE(PG8_SB(0, 0), b2, voffB);
            PG8_BAR; PG8_WAIT_L(0); PG8_MMA(0, 1, At, B1); PG8_BAR;
            PG8_LDA(At, 0, 1); PG8_STAGE(PG8_SA(0, 0), a2, voffA);
            PG8_BAR; PG8_WAIT_L(0); PG8_MMA(1, 0, At, B0); PG8_BAR; PG8_SCHED;
            PG8_STAGE(PG8_SB(0, 1), b2 + hstepB, voffB);
            PG8_WAIT_V(6); PG8_BAR; PG8_MMA(1, 1, At, B1); PG8_BAR;
            PG8_LDB(B0, 1, 0); PG8_SCHED; PG8_LDA(At, 1, 0); PG8_STAGE(PG8_SA(0, 1), a2 + hstepA, voffA);
            PG8_WAIT_L(8); PG8_BAR; PG8_WAIT_L(0); PG8_MMA(0, 0, At, B0); PG8_BAR; PG8_SCHED;
            PG8_LDB(B1, 1, 1); PG8_STAGE(PG8_SB(1, 0), b3, voffB);
            PG8_BAR; PG8_WAIT_L(0); PG8_MMA(0, 1, At, B1); PG8_BAR;
            PG8_LDA(At, 1, 1); PG8_STAGE(PG8_SA(1, 0), a3, voffA);
            PG8_BAR; PG8_WAIT_L(0); PG8_MMA(1, 0, At, B0); PG8_BAR; PG8_SCHED;
            PG8_STAGE(PG8_SB(1, 1), b3 + hstepB, voffB);
            PG8_WAIT_V(6); PG8_BAR; PG8_MMA(1, 1, At, B1); PG8_BAR;
            }
        }
        if constexpr (ALIGN_EPI) { if (wr == 0) PG8_BAR; }
        if constexpr (!Epi::AFTER_DRAIN) { E(acc, cur, wr, wc, fr, fq); S.done(cur); }
        if (!has_next) break;
#pragma unroll
        for (int a = 0; a < 2; ++a)
#pragma unroll
            for (int b = 0; b < 2; ++b)
#pragma unroll
                for (int m = 0; m < 4; ++m)
#pragma unroll
                    for (int n = 0; n < 2; ++n) acc[a][b][m][n] = (f32x4){0.f, 0.f, 0.f, 0.f};
        cur = nxt; cA = nA; cB = nB; ++ui;
        if constexpr (ALIGN_EPI) { if (wr == 1) PG8_BAR; }
    }
    PG8_WAIT_V(0);
    if constexpr (!ALIGN_EPI) { if (wr == 0) PG8_BAR; }
    PG8_BAR;
    if constexpr (Epi::AFTER_DRAIN) { E.fused(acc, cur, wr, wc, fr, fq, lds, wid, lane); S.done(cur); }
#undef PG8_SA
#undef PG8_SB
#undef PG8_STAGE
#undef PG8_LDA
#undef PG8_LDB
#undef PG8_MMA
#undef PG8_WAIT_V
#undef PG8_WAIT_L
#undef PG8_BAR
#undef PG8_SCHED
}
}
#define LAS __attribute__((address_space(3)))
typedef unsigned short bf16_t;
typedef short bf16x8 __attribute__((ext_vector_type(8)));
typedef short s16x4 __attribute__((ext_vector_type(4)));
typedef float f32x4 __attribute__((ext_vector_type(4)));
typedef float f32x16 __attribute__((ext_vector_type(16)));
typedef unsigned u32x4 __attribute__((ext_vector_type(4)));
using pg8::u32x2; using pg8::pk_bf16; using pg8::bf_lo; using pg8::bf_hi; using pg8::bf2f;
constexpr int T = 2048, NB = 4, M = NB * T, D = 2048, DFF = 5632, HYBN = 5888, MLAN = 1280;
constexpr size_t MiB = 1u << 20;
constexpr size_t WS_CTL = 0, WS_SSQ = 1 * MiB, WS_SSQ2 = 2 * MiB, WS_CUM = 3 * MiB, WS_SEL = 3 * MiB + 256 * 1024, WS_BPART = 3 * MiB + 512 * 1024, WS_BIASPE = 3 * MiB + 768 * 1024,
                 WS_ROPE128 = 4 * MiB, WS_ROPE64 = 5 * MiB, WS_HID = 6 * MiB, WS_KCVC = 7 * MiB;
constexpr size_t WS_W1T = 8 * MiB, WS_W2T = 184 * MiB, WS_HYBIN = 272 * MiB, WS_HYBOUT = 295 * MiB, WS_MLAIN = 303 * MiB, WS_UQKV = 308 * MiB, WS_MLAOUT = 315 * MiB, WS_CMPW1 = 323 * MiB;
constexpr size_t WS_XB = 327 * MiB, WS_ACT = 359 * MiB, WS_OBUF = 447 * MiB, WS_MIX = 479 * MiB;
constexpr size_t WS_PBUF = WS_MIX, WS_QR = WS_MIX + 92 * MiB, WS_CMPIN = WS_MIX + 108 * MiB, WS_OWIN = WS_MIX + 117 * MiB, WS_OCMP = WS_MIX + 133 * MiB;
constexpr size_t WS_C = WS_MIX, WS_QBUF = WS_MIX + 20 * MiB, WS_KVBUF = WS_MIX + 68 * MiB;
constexpr size_t WS_END = WS_MIX + 149 * MiB;
constexpr int LDS_BYTES = 147456, MISC_OFF = 131072;
constexpr float LOG2E = 1.4426950408889634f;

struct Args { const float* in[21]; float* out; unsigned char* ws; };

__device__ __forceinline__ float wave_sum(float v) {
#pragma unroll
    for (int o = 1; o < 64; o <<= 1) v += __shfl_xor(v, o);
    return v;
}
template <int MODE> __device__ __forceinline__ int mapcol(int n, int N) {
    if (MODE == 0) return n < N ? n : -1;
    if (MODE == 1) { const int t = n >> 8, r = n & 255; return r < 128 ? 128 * t + r : DFF + 128 * t + (r - 128); }
    if (MODE == 2) { if (n < 2560) return n; if (n < 5632) return n + 24; if (n < 5656) return 2560 + (n - 5632); if (n < 5664) return n; return -1; }
    return -1;
}
template <int MODE> __device__ __forceinline__ void transpose_item(const float* W, int K, int N, int NP, const float* gain, bf16_t* WT, LAS float* scr, int item, int lane) {
    const int nblk = NP / 32, kb = item / nblk, nb = item % nblk, k0 = 64 * kb, n0 = 32 * nb;
    const int sc = mapcol<MODE>(n0 + (lane & 31), N);
    float v[32];
#pragma unroll
    for (int i = 0; i < 32; ++i) { const int kk = 2 * i + (lane >> 5); v[i] = (sc >= 0) ? W[(size_t)(k0 + kk) * N + sc] : 0.f; }
    if (gain) {
#pragma unroll
        for (int i = 0; i < 32; ++i) v[i] *= gain[k0 + 2 * i + (lane >> 5)]; }
#pragma unroll
    for (int i = 0; i < 32; ++i) scr[(2 * i + (lane >> 5)) * 33 + (lane & 31)] = v[i];
    asm volatile("s_waitcnt lgkmcnt(0)" ::: "memory");
    const int c = lane & 7;
#pragma unroll
    for (int j = 0; j < 4; ++j) { const int n = (lane >> 3) + 8 * j; const LAS float* s = scr + (8 * c) * 33 + n;
        u32x4 o; o.x = pk_bf16(s[0 * 33], s[1 * 33]); o.y = pk_bf16(s[2 * 33], s[3 * 33]); o.z = pk_bf16(s[4 * 33], s[5 * 33]); o.w = pk_bf16(s[6 * 33], s[7 * 33]);
        *(u32x4*)(WT + (size_t)(n0 + n) * K + k0 + 8 * c) = o; }
    asm volatile("s_waitcnt lgkmcnt(0)" ::: "memory");
}
#define XB_TMO      128
#define XB_XCNT(j)  (256  + 64 * (j))
#define XB_XSUB(j)  (1280 + 64 * (j))
#define XB_XGEN(j)  (2304 + 64 * (j))
#define XB_TOP      3328
#define XB_TOPGEN   3392
#define XCD_BAR_WORDS 3456
#define XB_SPIN_CAP (1u << 18)

__device__ __forceinline__ unsigned xb_ld(unsigned* p)              { return __hip_atomic_load(p, __ATOMIC_RELAXED, __HIP_MEMORY_SCOPE_AGENT); }
__device__ __forceinline__ unsigned xb_add(unsigned* p, unsigned v) { return __hip_atomic_fetch_add(p, v, __ATOMIC_RELAXED, __HIP_MEMORY_SCOPE_AGENT); }
__device__ __forceinline__ unsigned xb_xcc_id() { return (unsigned)__builtin_amdgcn_s_getreg((3 << 11) | 20) & 0xFu; }
#define XB_SPIN(cond, bar) do { unsigned _sp = 0; while (cond) { __builtin_amdgcn_s_sleep(1); \
    if ((++_sp & 255u) == 0u) { if (xb_ld(&(bar)[XB_TMO])) break; if (_sp > XB_SPIN_CAP) { atomicAdd(&(bar)[XB_TMO], 1u); break; } } } } while (0)

struct XcdBarrier {
    unsigned* bar; unsigned x;
    volatile LAS unsigned* st;
};

__device__ __forceinline__ XcdBarrier xcd_barrier_post(unsigned* bar, volatile LAS unsigned* st) {
    XcdBarrier b; b.bar = bar; b.x = xb_xcc_id(); b.st = st;
    if (threadIdx.x == 0) (void)xb_add(&bar[XB_XCNT(b.x)], 1u);
    return b;
}
__device__ __forceinline__ void xcd_barrier_complete(unsigned* bar, unsigned x, unsigned& nloc, unsigned& nx) {
    const unsigned G = gridDim.x * gridDim.y * gridDim.z;
    unsigned sum, cnt, mine, sp = 0u;
    for (;;) {
        sum = 0u; cnt = 0u; mine = 0u;
#pragma unroll
        for (unsigned j = 0; j < 16; ++j) { const unsigned c = xb_ld(&bar[XB_XCNT(j)]); sum += c; cnt += (c > 0u) ? 1u : 0u; mine = (j == x) ? c : mine; }
        if (sum == G) break;
        __builtin_amdgcn_s_sleep(1);
        if ((++sp & 255u) == 0u) { if (xb_ld(&bar[XB_TMO])) break; if (sp > XB_SPIN_CAP) { atomicAdd(&bar[XB_TMO], 1u); break; } }
    }
    nloc = mine > 0u ? mine : 1u; nx = cnt > 0u ? cnt : 1u;
}

__device__ __forceinline__ void xcd_barrier(const XcdBarrier& b) {
    asm volatile("s_waitcnt vmcnt(0)" ::: "memory");
    __syncthreads();
    if (threadIdx.x == 0) {
        unsigned* bar = b.bar;
        __builtin_amdgcn_s_waitcnt(0);
        unsigned nloc = b.st[0], nx = b.st[1];
        if (nloc == 0u) { xcd_barrier_complete(bar, b.x, nloc, nx); b.st[0] = nloc; b.st[1] = nx; }
        const unsigned old = xb_add(&bar[XB_XSUB(b.x)], 1u);
        const unsigned gen = old / nloc;
        if (old + 1u == (gen + 1u) * nloc) {
            __builtin_amdgcn_fence(__ATOMIC_RELEASE, "agent");
            asm volatile("s_waitcnt vmcnt(0)" ::: "memory");
            const unsigned og = xb_add(&bar[XB_TOP], 1u);
            const unsigned tg = og / nx;
            if (og + 1u == (tg + 1u) * nx) xb_add(&bar[XB_TOPGEN], 1u);
            else XB_SPIN(xb_ld(&bar[XB_TOPGEN]) == tg, bar);
            __builtin_amdgcn_fence(__ATOMIC_ACQUIRE, "agent");
            xb_add(&bar[XB_XGEN(b.x)], 1u);
            asm volatile("s_waitcnt vmcnt(0)" ::: "memory");
        } else {
            XB_SPIN(xb_ld(&bar[XB_XGEN(b.x)]) == gen, bar);
            __builtin_amdgcn_fence(__ATOMIC_ACQUIRE, "agent");
            asm volatile("s_waitcnt vmcnt(0)" ::: "memory");
        }
    }
    __syncthreads();
}

#define MFMA32(a, b, c) __builtin_amdgcn_mfma_f32_32x32x16_bf16((a), (b), (c), 0, 0, 0)
__device__ __forceinline__ s16x4 tr_read(LAS unsigned char* p) { return __builtin_amdgcn_ds_read_tr16_b64_v4i16((LAS s16x4*)p); }
__device__ __forceinline__ float fast_exp2(float x) { return __builtin_amdgcn_exp2f(x); }
__device__ __forceinline__ float sigmoid_f(float x) { return __builtin_amdgcn_rcpf(1.f + __expf(-x)); }
constexpr int KP128 = 272, KP192 = 400, VP = 320;
struct AttnArgs {
    const bf16_t* Q; int ldq, qhs;
    const bf16_t* K; int ldk, khs;
    const bf16_t* K2; int ldk2;
    const bf16_t* V; int ldv, vhs;
    bf16_t* O; int ldo, ocol0;
    float sc2;
    const float* CUM2;
    const unsigned* SEL;
    const bf16_t* P;
    const bf16_t* OCMP; const bf16_t* OWIN;
};
template <int MODE, int DK, int HG>
__device__ __forceinline__ void attn_unit(LAS unsigned char* lds, const AttnArgs& A, int b, int kvh, int qb) {
    constexpr int KPB = (DK == 128) ? KP128 : KP192, NKK = DK / 16, QT = 256 / HG;
    constexpr int KS_OFF = 0, VS_OFF = 64 * KPB, CK_OFF = VS_OFF + 64 * VP, STG = CK_OFF + 256, UM_OFF = 2 * STG;
    int tid_op = threadIdx.x; asm volatile("" : "+v"(tid_op));
    const int tid = tid_op, w = __builtin_amdgcn_readfirstlane(tid >> 6), lane = tid & 63, r = lane & 31, hh = lane >> 5;
    const int hd = (HG == 4) ? kvh * 4 + (w & 3) : kvh;
    const int t0 = qb * QT, tw0 = t0 + 32 * (w / HG), t = tw0 + r; const size_t mrow = (size_t)b * T + t; const size_t brow = (size_t)b * T;
    LAS unsigned* ums = (LAS unsigned*)(lds + UM_OFF);
    bf16x8 qf[NKK];
    { const bf16_t* qp = A.Q + mrow * A.ldq + (size_t)hd * A.qhs + 8 * hh;
#pragma unroll
      for (int kk = 0; kk < NKK; ++kk) qf[kk] = *(const bf16x8*)(qp + 16 * kk); }
    float cq = 0.f; unsigned selw = 0xffffffffu; unsigned um = 0xffffffffu;
    if (MODE == 1) cq = A.CUM2[mrow * 8 + hd];
    if (MODE == 3) {
        selw = A.SEL[mrow * 2 + kvh];
        __syncthreads();
        if (w == 0) { unsigned v = A.SEL[(brow + t0 + lane) * 2 + kvh];
#pragma unroll
            for (int o = 1; o < 64; o <<= 1) v |= __shfl_xor(v, o);
            if (lane == 0) ums[0] = v; }
        __syncthreads(); um = ums[0];
    }
    int j0, j1;
    if (MODE == 2) { j0 = t0 / 64 - 8; if (j0 < 0) j0 = 0; j1 = t0 / 64 + 1; } else { j0 = 0; j1 = (t0 + QT) / 64; }
    f32x16 Oa[4];
#pragma unroll
    for (int i = 0; i < 4; ++i)
#pragma unroll
        for (int e = 0; e < 16; ++e) Oa[i][e] = 0.f;
    float mrun = -1e30f, lrun = 0.f;
    u32x4 kreg[3], vreg[2]; float ckreg = 0.f;
#define AT_LOAD_TILE(jj) do { const size_t kvrow = brow + (size_t)(jj) * 64; \
        _Pragma("unroll") for (int i = 0; i < 2; ++i) { const int c = tid + 512 * i, row = c >> 4, cc = c & 15; \
            kreg[i] = *(const u32x4*)(A.K + (kvrow + row) * A.ldk + (size_t)kvh * A.khs + 8 * cc); \
            vreg[i] = *(const u32x4*)(A.V + (kvrow + row) * A.ldv + (size_t)kvh * A.vhs + 8 * cc); } \
        if (DK == 192) { const int row = tid >> 3, cc = tid & 7; kreg[2] = *(const u32x4*)(A.K2 + (kvrow + row) * A.ldk2 + 8 * cc); } \
        if (MODE == 1) { if (tid < 64) ckreg = A.CUM2[(kvrow + tid) * 8 + hd]; } } while (0)
#define AT_STORE_TILE(sb) do { LAS unsigned char* Ks = lds + (sb) * STG + KS_OFF; LAS unsigned char* Vs = lds + (sb) * STG + VS_OFF; LAS float* cks = (LAS float*)(lds + (sb) * STG + CK_OFF); \
        _Pragma("unroll") for (int i = 0; i < 2; ++i) { const int c = tid + 512 * i, row = c >> 4, cc = c & 15; \
            *(LAS u32x4*)(Ks + row * KPB + 16 * cc) = kreg[i]; *(LAS u32x4*)(Vs + row * VP + 16 * cc) = vreg[i]; } \
        if (DK == 192) { const int row = tid >> 3, cc = tid & 7; *(LAS u32x4*)(Ks + row * KPB + 256 + 16 * cc) = kreg[2]; } \
        if (MODE == 1) { if (tid < 64) cks[tid] = ckreg; } } while (0)
#define AT_NEXT(jj, res) do { int q_ = (jj) + 1; if (MODE == 3) { while (q_ < j1 && !((um >> q_) & 1u)) ++q_; } res = q_; } while (0)
    int j = j0; int cur = 0;
    __syncthreads();
    AT_LOAD_TILE(j); AT_STORE_TILE(0);
    __syncthreads();
    const int trq = (lane & 15) >> 2, trp = lane & 3, trb = (lane >> 4) & 1;
    while (j < j1) {
        int jn; AT_NEXT(j, jn);
        if (jn < j1) AT_LOAD_TILE(jn);
        LAS unsigned char* Ks = lds + cur * STG + KS_OFF; LAS unsigned char* Vs = lds + cur * STG + VS_OFF; LAS float* cks = (LAS float*)(lds + cur * STG + CK_OFF); (void)cks;
        const int kv0 = j * 64;
        const bool active = (kv0 <= tw0 + 31) && (MODE != 2 || kv0 + 63 > tw0 - 512);
        if (active) {
            f32x16 S[2];
#pragma unroll
            for (int kb = 0; kb < 2; ++kb) {
#pragma unroll
                for (int e = 0; e < 16; ++e) S[kb][e] = 0.f;
#pragma unroll
                for (int kk = 0; kk < NKK; ++kk) { const bf16x8 kf = *(const LAS bf16x8*)(Ks + (32 * kb + r) * KPB + (16 * kk + 8 * hh) * 2); S[kb] = MFMA32(kf, qf[kk], S[kb]); }
            }
            const bool need_mask = (kv0 + 63 > tw0) || (MODE == 2 && kv0 <= tw0 + 31 - 512);
            const bool selok = (MODE != 3) || ((selw >> j) & 1u);
            float mloc = -1e30f;
            if (need_mask) {
#pragma unroll
            for (int kb = 0; kb < 2; ++kb)
#pragma unroll
                for (int g4 = 0; g4 < 4; ++g4) {
                    f32x4 ck4 = {0.f, 0.f, 0.f, 0.f}; if (MODE == 1) ck4 = *(const LAS f32x4*)(cks + 32 * kb + 8 * g4 + 4 * hh);
#pragma unroll
                    for (int e = 0; e < 4; ++e) { const int key = kv0 + 32 * kb + 8 * g4 + 4 * hh + e;
                        float s2 = S[kb][4 * g4 + e] * A.sc2; if (MODE == 1) s2 += cq - ck4[e];
                        bool valid = selok && (key <= t); if (MODE == 2) valid = valid && (key > t - 512);
                        s2 = valid ? s2 : -1e30f; S[kb][4 * g4 + e] = s2; mloc = fmaxf(mloc, s2); }
                }
            } else {
#pragma unroll
            for (int kb = 0; kb < 2; ++kb)
#pragma unroll
                for (int g4 = 0; g4 < 4; ++g4) {
                    f32x4 ck4 = {0.f, 0.f, 0.f, 0.f}; if (MODE == 1) ck4 = *(const LAS f32x4*)(cks + 32 * kb + 8 * g4 + 4 * hh);
#pragma unroll
                    for (int e = 0; e < 4; ++e) {
                        float s2 = S[kb][4 * g4 + e] * A.sc2; if (MODE == 1) s2 += cq - ck4[e];
                        if (MODE == 3) s2 = selok ? s2 : -1e30f;
                        S[kb][4 * g4 + e] = s2; mloc = fmaxf(mloc, s2); }
                }
            }
            mloc = fmaxf(mloc, __shfl_xor(mloc, 32));
            const float mnew = fmaxf(mrun, mloc); const float muse = (mnew < -1e29f) ? 0.f : mnew;
            const float alpha = fast_exp2(mrun - muse); const bool anychg = __builtin_amdgcn_ballot_w64(mnew > mrun) != 0ull; mrun = mnew;
            float psum = 0.f;
#pragma unroll
            for (int kb = 0; kb < 2; ++kb)
#pragma unroll
                for (int e = 0; e < 16; ++e) { const float p = fast_exp2(S[kb][e] - muse); S[kb][e] = p; psum += p; }
            lrun = lrun * alpha + psum;
            if (anychg) {
#pragma unroll
            for (int i = 0; i < 4; ++i)
#pragma unroll
                for (int e = 0; e < 16; ++e) Oa[i][e] *= alpha;
            }
            bf16x8 pf[2][2];
#pragma unroll
            for (int kb = 0; kb < 2; ++kb)
#pragma unroll
                for (int s = 0; s < 2; ++s) { u32x4 pw; pw.x = pk_bf16(S[kb][8 * s], S[kb][8 * s + 1]); pw.y = pk_bf16(S[kb][8 * s + 2], S[kb][8 * s + 3]); pw.z = pk_bf16(S[kb][8 * s + 4], S[kb][8 * s + 5]); pw.w = pk_bf16(S[kb][8 * s + 6], S[kb][8 * s + 7]);
                    pf[kb][s] = __builtin_bit_cast(bf16x8, pw); }
#pragma unroll
            for (int dvb = 0; dvb < 4; ++dvb)
#pragma unroll
                for (int kb = 0; kb < 2; ++kb)
#pragma unroll
                    for (int s = 0; s < 2; ++s) { LAS unsigned char* vp = Vs + (32 * kb + 16 * s + 4 * hh + trq) * VP + (32 * dvb + 16 * trb + 4 * trp) * 2;
                        const s16x4 lo = tr_read(vp), hi = tr_read(vp + 8 * VP);
                        const bf16x8 vf = __builtin_shufflevector(lo, hi, 0, 1, 2, 3, 4, 5, 6, 7);
                        Oa[dvb] = MFMA32(vf, pf[kb][s], Oa[dvb]); }
        }
        if (jn < j1) AT_STORE_TILE(cur ^ 1);
        __syncthreads();
        cur ^= 1; j = jn;
    }
    const float ltot = lrun + __shfl_xor(lrun, 32);
    float inv = ltot > 0.f ? 1.f / ltot : 0.f;
    if (MODE == 2) inv *= sigmoid_f(bf2f(A.P[mrow * HYBN + 5632 + hd * 3 + 2]));
    if (MODE == 3) inv *= sigmoid_f(bf2f(A.P[mrow * HYBN + 5632 + hd * 3 + 1]));
    bf16_t* op = A.O + mrow * A.ldo + A.ocol0 + hd * 128 + 4 * hh;
#pragma unroll
    for (int dvb = 0; dvb < 4; ++dvb)
#pragma unroll
        for (int g4 = 0; g4 < 4; ++g4) {
            float v0 = Oa[dvb][4 * g4] * inv, v1 = Oa[dvb][4 * g4 + 1] * inv, v2 = Oa[dvb][4 * g4 + 2] * inv, v3 = Oa[dvb][4 * g4 + 3] * inv;
            if (MODE == 3) { const size_t o = mrow * 1024 + hd * 128 + 32 * dvb + 8 * g4 + 4 * hh; const u32x2 a = *(const u32x2*)(A.OCMP + o), c = *(const u32x2*)(A.OWIN + o);
                v0 += bf_lo(a.x) + bf_lo(c.x); v1 += bf_hi(a.x) + bf_hi(c.x); v2 += bf_lo(a.y) + bf_lo(c.y); v3 += bf_hi(a.y) + bf_hi(c.y); }
            u32x2 o2; o2.x = pk_bf16(v0, v1); o2.y = pk_bf16(v2, v3); *(u32x2*)(op + 32 * dvb + 8 * g4) = o2; }
}
#undef AT_LOAD_TILE
#undef AT_STORE_TILE
#undef AT_NEXT
__device__ __forceinline__ void cmp_unit(LAS unsigned char* lds, const bf16_t* P, const bf16_t* KC, const bf16_t* VC, bf16_t* OCMP, unsigned* SEL, int b, int g, int qb) {
    constexpr int VS_OFF = 128 * KP128, IMP_OFF = VS_OFF + 128 * VP;
    int tid_op = threadIdx.x; asm volatile("" : "+v"(tid_op));
    const int tid = tid_op, w = __builtin_amdgcn_readfirstlane(tid >> 6), lane = tid & 63, r = lane & 31, hh = lane >> 5;
    const int hd = g * 4 + (w & 3), t0 = qb * 64, t = t0 + 32 * (w >> 2) + r; const size_t mrow = (size_t)b * T + t;
    LAS unsigned char* Ks = lds; LAS unsigned char* Vs = lds + VS_OFF; LAS float* IMPW = (LAS float*)(lds + IMP_OFF);
    __syncthreads();
    { const bf16_t* kc = KC + (size_t)(b * 2 + g) * 128 * 128; const bf16_t* vc = VC + (size_t)(b * 2 + g) * 128 * 128;
#pragma unroll
      for (int i = 0; i < 4; ++i) { const int c = tid + 512 * i, row = c >> 4, cc = c & 15;
          *(LAS u32x4*)(Ks + row * KP128 + 16 * cc) = *(const u32x4*)(kc + row * 128 + 8 * cc);
          *(LAS u32x4*)(Vs + row * VP + 16 * cc) = *(const u32x4*)(vc + row * 128 + 8 * cc); } }
    bf16x8 qf[8];
    { const bf16_t* qp = P + mrow * HYBN + hd * 128 + 8 * hh;
#pragma unroll
      for (int kk = 0; kk < 8; ++kk) qf[kk] = *(const bf16x8*)(qp + 16 * kk); }
    __syncthreads();
    f32x16 S[4];
#pragma unroll
    for (int kb = 0; kb < 4; ++kb) {
#pragma unroll
        for (int e = 0; e < 16; ++e) S[kb][e] = 0.f;
#pragma unroll
        for (int kk = 0; kk < 8; ++kk) { const bf16x8 kf = *(const LAS bf16x8*)(Ks + (32 * kb + r) * KP128 + (16 * kk + 8 * hh) * 2); S[kb] = MFMA32(kf, qf[kk], S[kb]); }
    }
    const float sc2 = 0.08838834764831845f * LOG2E;
    float mloc = -1e30f;
#pragma unroll
    for (int kb = 0; kb < 4; ++kb)
#pragma unroll
        for (int e = 0; e < 16; ++e) { const int n = 32 * kb + (e & 3) + 8 * (e >> 2) + 4 * hh; const bool valid = (n < 127) && (16 * n + 31 <= t);
            const float s2 = valid ? S[kb][e] * sc2 : -1e30f; S[kb][e] = s2; mloc = fmaxf(mloc, s2); }
    mloc = fmaxf(mloc, __shfl_xor(mloc, 32));
    const float muse = (mloc < -1e29f) ? 0.f : mloc;
    float psum = 0.f;
#pragma unroll
    for (int kb = 0; kb < 4; ++kb)
#pragma unroll
        for (int e = 0; e < 16; ++e) { const float p = fast_exp2(S[kb][e] - muse); S[kb][e] = p; psum += p; }
    const float ltot = psum + __shfl_xor(psum, 32);
    const float inv = ltot > 0.f ? 1.f / ltot : 0.f;
    {
        float prevrecv = 0.f;
#pragma unroll
        for (int kb = 0; kb < 4; ++kb)
#pragma unroll
            for (int g4 = 0; g4 < 4; ++g4) { const int Gi = 4 * kb + g4;
                const float p0 = S[kb][4 * g4], p1 = S[kb][4 * g4 + 1], p2 = S[kb][4 * g4 + 2], p3 = S[kb][4 * g4 + 3];
                const float ai = ((p0 + p1) + p2 + 0.5f * p3) * inv, bi = 0.5f * p3 * inv;
                const float recv = __shfl_xor(bi, 32);
                const float tot = ai + (hh ? recv : prevrecv); prevrecv = recv;
                IMPW[(w * 32 + r) * 33 + 2 * Gi + hh] = tot; }
    }
    f32x16 Oa[4];
#pragma unroll
    for (int i = 0; i < 4; ++i)
#pragma unroll
        for (int e = 0; e < 16; ++e) Oa[i][e] = 0.f;
    const int trq = (lane & 15) >> 2, trp = lane & 3, trb = (lane >> 4) & 1;
#pragma unroll
    for (int kb = 0; kb < 4; ++kb)
#pragma unroll
        for (int s = 0; s < 2; ++s) { u32x4 pw; pw.x = pk_bf16(S[kb][8 * s], S[kb][8 * s + 1]); pw.y = pk_bf16(S[kb][8 * s + 2], S[kb][8 * s + 3]); pw.z = pk_bf16(S[kb][8 * s + 4], S[kb][8 * s + 5]); pw.w = pk_bf16(S[kb][8 * s + 6], S[kb][8 * s + 7]);
            const bf16x8 pf = __builtin_bit_cast(bf16x8, pw);
#pragma unroll
            for (int dvb = 0; dvb < 4; ++dvb) { LAS unsigned char* vp = Vs + (32 * kb + 16 * s + 4 * hh + trq) * VP + (32 * dvb + 16 * trb + 4 * trp) * 2;
                const s16x4 lo = tr_read(vp), hi = tr_read(vp + 8 * VP);
                const bf16x8 vf = __builtin_shufflevector(lo, hi, 0, 1, 2, 3, 4, 5, 6, 7);
                Oa[dvb] = MFMA32(vf, pf, Oa[dvb]); } }
    const float og = inv * sigmoid_f(bf2f(P[mrow * HYBN + 5632 + hd * 3 + 0]));
    bf16_t* op = OCMP + mrow * 1024 + hd * 128 + 4 * hh;
#pragma unroll
    for (int dvb = 0; dvb < 4; ++dvb)
#pragma unroll
        for (int g4 = 0; g4 < 4; ++g4) { u32x2 o2; o2.x = pk_bf16(Oa[dvb][4 * g4] * og, Oa[dvb][4 * g4 + 1] * og); o2.y = pk_bf16(Oa[dvb][4 * g4 + 2] * og, Oa[dvb][4 * g4 + 3] * og); *(u32x2*)(op + 32 * dvb + 8 * g4) = o2; }
    __syncthreads();
    if (tid < 64) {
        const int sub = tid >> 5, rr = tid & 31; LAS float* ip = IMPW + ((4 * sub) * 32 + rr) * 33;
        const int cur = qb; unsigned mask;
        if (cur <= 7) mask = (2u << cur) - 1u;
        else {
            for (int j = 1; j <= cur - 2; ++j) ip[j] = ((ip[j] + ip[32 * 33 + j]) + ip[2 * 32 * 33 + j]) + ip[3 * 32 * 33 + j];
            mask = 1u | (1u << cur) | (1u << (cur - 1));
            for (int rd = 0; rd < 5; ++rd) { int best = 1; float bv = -1.f;
                for (int j = 1; j <= cur - 2; ++j) { const float v = ip[j]; if (!((mask >> j) & 1u) && v > bv) { bv = v; best = j; } }
                mask |= 1u << best; }
        }
        SEL[((size_t)b * T + t0 + tid) * 2 + g] = mask;
    }
}
__device__ __forceinline__ int fetch_unit(unsigned* ctr, LAS int* slot) {
    __syncthreads();
    if (threadIdx.x == 0) *slot = (int)atomicAdd(ctr, 1u);
    __syncthreads();
    return *slot;
}
__global__ void __launch_bounds__(512, 2) mega_fwd(Args a) {
    extern __shared__ __attribute__((aligned(16))) unsigned char lds_raw[];
    LAS unsigned char* lds = (LAS unsigned char*)lds_raw;
    LAS int* slot = (LAS int*)(lds + MISC_OFF);
    cg::grid_group grid = cg::this_grid();
    const int tid = threadIdx.x, lane = tid & 63, wave = tid >> 6, G = gridDim.x, bid = blockIdx.x;
    const int gw = bid * 8 + wave, NGW = G * 8, gtid = bid * 512 + tid, NGT = G * 512;
    unsigned char* ws = a.ws;
    unsigned* ctl = (unsigned*)(ws + WS_CTL);
    float* SSQ = (float*)(ws + WS_SSQ); float* SSQ2 = (float*)(ws + WS_SSQ2); float* CUM2 = (float*)(ws + WS_CUM); unsigned* SEL = (unsigned*)(ws + WS_SEL);
    float* BPART = (float*)(ws + WS_BPART); float* BIASPE = (float*)(ws + WS_BIASPE); float* ROPE128 = (float*)(ws + WS_ROPE128); float* ROPE64 = (float*)(ws + WS_ROPE64);
    bf16_t* HID = (bf16_t*)(ws + WS_HID); bf16_t* KCVC = (bf16_t*)(ws + WS_KCVC);
    bf16_t* HYBIN = (bf16_t*)(ws + WS_HYBIN); bf16_t* HYBOUT = (bf16_t*)(ws + WS_HYBOUT); bf16_t* MLAIN = (bf16_t*)(ws + WS_MLAIN); bf16_t* UQKV = (bf16_t*)(ws + WS_UQKV);
    bf16_t* MLAOUT = (bf16_t*)(ws + WS_MLAOUT); bf16_t* CMPW1 = (bf16_t*)(ws + WS_CMPW1);
    bf16_t* XB = (bf16_t*)(ws + WS_XB); bf16_t* ACT = (bf16_t*)(ws + WS_ACT); bf16_t* OBUF = (bf16_t*)(ws + WS_OBUF);
    bf16_t* PBUF = (bf16_t*)(ws + WS_PBUF); bf16_t* QR = (bf16_t*)(ws + WS_QR); bf16_t* CMPIN = (bf16_t*)(ws + WS_CMPIN); bf16_t* OWIN = (bf16_t*)(ws + WS_OWIN); bf16_t* OCMP = (bf16_t*)(ws + WS_OCMP);
    bf16_t* CB = (bf16_t*)(ws + WS_C); bf16_t* QBUF = (bf16_t*)(ws + WS_QBUF); bf16_t* KVBUF = (bf16_t*)(ws + WS_KVBUF);
    float* X = a.out;

    if (bid == 0) { for (int i = tid; i < XCD_BAR_WORDS; i += 512) __hip_atomic_store(ctl + 4096 + i, 0u, __ATOMIC_RELAXED, __HIP_MEMORY_SCOPE_AGENT); }
    if (tid < 2) ((volatile LAS unsigned*)(lds + MISC_OFF + 32))[tid] = 0u;
    if (gtid < 64) ctl[gtid * 64] = 0u;
    __threadfence();
    grid.sync();
    XcdBarrier xbar = xcd_barrier_post(ctl + 4096, (volatile LAS unsigned*)(lds + MISC_OFF + 32));
#pragma unroll 1
    for (int rep = 0; rep < 1 + PROBE_P0X2; ++rep) {
    {
        LAS float* scr = (LAS float*)(lds + wave * 16384);
#define TJOBX(MODE, W, K, N, NP, gain, dst, gw_, ngw_) for (int it = (gw_); it < ((K) / 64) * ((NP) / 32); it += (ngw_)) transpose_item<MODE>(W, K, N, NP, gain, dst, scr, it, lane)
#define TJOBR(MODE, W, K, N, NP, gain, dst, gw_, ngw_, it0, it1) for (int it = (it0) + (gw_); it < (it1); it += (ngw_)) transpose_item<MODE>(W, K, N, NP, gain, dst, scr, it, lane)
        TJOBX(1, a.in[2], 2048, 11264, 11264, a.in[1], (bf16_t*)(ws + WS_W1T), gw, NGW);
        TJOBX(0, a.in[3], 5632, 2048, 2048, (const float*)nullptr, (bf16_t*)(ws + WS_W2T), gw, NGW);
        TJOBR(1, a.in[6], 2048, 11264, 11264, a.in[5], (bf16_t*)(ws + WS_W1T + (size_t)1 * 44 * MiB), gw, NGW, 6752, 11264);
        TJOBR(1, a.in[2] + (size_t)2048 * 11264, 2048, 11264, 11264, a.in[1] + 2048, (bf16_t*)(ws + WS_W1T + (size_t)2 * 44 * MiB), gw, NGW, 6656, 11264);
        TJOBR(1, a.in[6] + (size_t)2048 * 11264, 2048, 11264, 11264, a.in[5] + 2048, (bf16_t*)(ws + WS_W1T + (size_t)3 * 44 * MiB), gw, NGW, 9088, 11264);
    }
    for (int m = gw; m < M; m += NGW) {
        const f32x4* xr = (const f32x4*)(a.in[0] + (size_t)m * D) + lane; u32x2* xo = (u32x2*)(XB + (size_t)m * D) + lane; float s = 0.f;
#pragma unroll
        for (int j = 0; j < 8; ++j) { const f32x4 v = xr[64 * j]; s += (v[0] * v[0] + v[1] * v[1]) + (v[2] * v[2] + v[3] * v[3]); u32x2 o; o.x = pk_bf16(v[0], v[1]); o.y = pk_bf16(v[2], v[3]); xo[64 * j] = o; }
        s = wave_sum(s);
        if (lane < 32) SSQ[(size_t)m * 32 + lane] = lane == 0 ? s : 0.f;
    }
    for (int i = gtid; i < 2048 * 64; i += NGT) { const int t = i >> 6, ii = i & 63; const float e = (float)(2 * ii) / 128.f; const float pw = (float)pow(10000.0, (double)e); const float inv = 1.0f / pw; const float ang = (float)t * inv;
        ROPE128[2 * i] = cosf(ang); ROPE128[2 * i + 1] = sinf(ang); }
    for (int i = gtid; i < 2048 * 32; i += NGT) { const int t = i >> 5, ii = i & 31; const float e = (float)(2 * ii) / 64.f; const float pw = (float)pow(10000.0, (double)e); const float inv = 1.0f / pw; const float ang = (float)t * inv;
        ROPE64[2 * i] = cosf(ang); ROPE64[2 * i + 1] = sinf(ang); }
    if (bid < 64) { const int kv = tid >> 8, c = tid & 255; const float* pe = a.in[10] + kv * 4096 + bid * 64; const float* w1 = a.in[11] + (size_t)kv * 4096 * 256 + (size_t)bid * 64 * 256 + c; float s = 0.f;
#pragma unroll 8
        for (int k = 0; k < 64; ++k) s += pe[k] * w1[(size_t)k * 256];
        BPART[bid * 512 + tid] = s; }
    }
    GSYNC();

#pragma unroll 1
    for (int k = 0; k < 4; ++k) {
#pragma unroll 1
        for (int rep = 0; rep < 1 + PROBE_UPX2; ++rep) {
            pg8::Gemm g{XB, XB, (const bf16_t*)(ws + WS_W1T + (size_t)k * 44 * MiB), M, 11264, 2048, 2048, 1 << 30};
            pg8::StaticOrder S; S.init(M, 11264, G, bid);
            pg8::EpiSwiglu E{ACT, DFF, SSQ};
            pg8::gemm_phase<pg8::EpiSwiglu, pg8::StaticOrder, true, true>(lds, g, S, E);
        }
        if (bid >= G / 2) {
            int tid_o = threadIdx.x; asm volatile("" : "+v"(tid_o)); const int lane = tid_o & 63, wave = __builtin_amdgcn_readfirstlane(tid_o >> 6);
            LAS float* scr = (LAS float*)(lds + wave * 16384);
            const int tgw = (bid - G / 2) * 8 + wave, TNG = (G - G / 2) * 8;
            if (k == 0) {
                TJOBX(2, a.in[8], 2048, 5664, 5888, a.in[4], HYBIN, tgw, TNG);
                TJOBX(0, a.in[9], 2048, 2048, 2048, (const float*)nullptr, HYBOUT, tgw, TNG);
                TJOBX(0, a.in[11], 4096, 256, 256, (const float*)nullptr, CMPW1, tgw, TNG);
                TJOBX(0, a.in[11] + (size_t)4096 * 256, 4096, 256, 256, (const float*)nullptr, CMPW1 + (size_t)256 * 4096, tgw, TNG);
                TJOBR(1, a.in[6], 2048, 11264, 11264, a.in[5], (bf16_t*)(ws + WS_W1T + (size_t)1 * 44 * MiB), tgw, TNG, 0, 3680);
            } else if (k == 1) {
                TJOBX(0, a.in[7], 5632, 2048, 2048, (const float*)nullptr, (bf16_t*)(ws + WS_W2T + (size_t)1 * 22 * MiB), tgw, TNG);
                TJOBR(1, a.in[2] + (size_t)2048 * 11264, 2048, 11264, 11264, a.in[1] + 2048, (bf16_t*)(ws + WS_W1T + (size_t)2 * 44 * MiB), tgw, TNG, 0, 6656);
            } else if (k == 2) {
                TJOBX(0, a.in[3] + (size_t)5632 * 2048, 5632, 2048, 2048, (const float*)nullptr, (bf16_t*)(ws + WS_W2T + (size_t)2 * 22 * MiB), tgw, TNG);
                TJOBX(0, a.in[14], 2048, 1088, 1280, a.in[4] + 2048, MLAIN, tgw, TNG);
                TJOBX(0, a.in[17], 512, 3072, 3072, a.in[15], UQKV, tgw, TNG);
                TJOBX(0, a.in[18], 512, 4096, 4096, a.in[16], UQKV + (size_t)3072 * 512, tgw, TNG);
                TJOBX(0, a.in[19], 2048, 2048, 2048, (const float*)nullptr, MLAOUT, tgw, TNG);
                TJOBR(1, a.in[6] + (size_t)2048 * 11264, 2048, 11264, 11264, a.in[5] + 2048, (bf16_t*)(ws + WS_W1T + (size_t)3 * 44 * MiB), tgw, TNG, 0, 1728);
            } else {
                TJOBX(0, a.in[7] + (size_t)5632 * 2048, 5632, 2048, 2048, (const float*)nullptr, (bf16_t*)(ws + WS_W2T + (size_t)3 * 22 * MiB), tgw, TNG);
            }
        }
        GSYNC();
        {
            pg8::Gemm g{ACT, ACT, (const bf16_t*)(ws + WS_W2T + (size_t)k * 22 * MiB), M, 2048, DFF, DFF, 1 << 30};
            pg8::StaticOrder S; S.init(M, 2048, G, bid);
            pg8::EpiResid E{k == 0 ? a.in[0] : X, X, XB, SSQ, 0.5f};
            pg8::gemm_phase<pg8::EpiResid, pg8::StaticOrder, true, true>(lds, g, S, E);
        }
        GSYNC();
        if (k == 0) {
            {
                pg8::Gemm g{XB, XB, HYBIN, M, HYBN, 2048, 2048, 1 << 30};
                pg8::StaticOrder S; S.init(M, HYBN, G, bid);
                pg8::EpiScale<8, false> E{PBUF, HYBN, PBUF, HYBN, 1 << 30, SSQ, 0, 0, 1.f / 2048.f, nullptr};
                pg8::gemm_phase<pg8::EpiScale<8, false>, pg8::StaticOrder, true, true>(lds, g, S, E);
            }
            if (bid >= 224 && G == 256) {
                int tid_o = threadIdx.x; asm volatile("" : "+v"(tid_o)); const int lane = tid_o & 63, wave = __builtin_amdgcn_readfirstlane(tid_o >> 6);
                LAS float* scr = (LAS float*)(lds + wave * 16384);
                TJOBR(1, a.in[6], 2048, 11264, 11264, a.in[5], (bf16_t*)(ws + WS_W1T + (size_t)1 * 44 * MiB), (bid - 224) * 8 + wave, 32 * 8, 3680, 6752);
            } else if (G != 256) {
                int tid_o = threadIdx.x; asm volatile("" : "+v"(tid_o)); const int lane = tid_o & 63, wave = __builtin_amdgcn_readfirstlane(tid_o >> 6);
                LAS float* scr = (LAS float*)(lds + wave * 16384);
                TJOBR(1, a.in[6], 2048, 11264, 11264, a.in[5], (bf16_t*)(ws + WS_W1T + (size_t)1 * 44 * MiB), bid * 8 + wave, G * 8, 3680, 6752);
            }
            GSYNC();
            {
                int tid_o = threadIdx.x; asm volatile("" : "+v"(tid_o)); const int tid = tid_o, lane = tid & 63, wave = __builtin_amdgcn_readfirstlane(tid >> 6), gw = bid * 8 + wave, gtid = bid * 512 + tid; (void)lane; (void)gw; (void)gtid;
                for (int i = gtid; i < M * 12 * 8; i += NGT) {
                    const int c8 = i & 7, u = (i >> 3) % 12, m = i / 96, t = m & (T - 1);
                    const bf16_t* src; bf16_t* dst;
                    if (u < 8) { src = PBUF + (size_t)m * HYBN + u * 128; dst = QR + (size_t)m * 1024 + u * 128; }
                    else if (u < 10) { src = PBUF + (size_t)m * HYBN + 1536 + (u - 8) * 128; dst = (bf16_t*)src; }
                    else { src = PBUF + (size_t)m * HYBN + 2048 + (u - 10) * 128; dst = (bf16_t*)src; }
                    const u32x4 x1 = *(const u32x4*)(src + 8 * c8), x2 = *(const u32x4*)(src + 64 + 8 * c8);
                    const f32x4* csp = (const f32x4*)(ROPE128 + ((size_t)t * 64 + 8 * c8) * 2);
                    u32x4 o1, o2;
#pragma unroll
                    for (int q = 0; q < 4; ++q) { const f32x4 cs = csp[q]; const float a0 = bf_lo(x1[q]), a1 = bf_hi(x1[q]), b0 = bf_lo(x2[q]), b1 = bf_hi(x2[q]);
                        o1[q] = pk_bf16(a0 * cs[0] - b0 * cs[1], a1 * cs[2] - b1 * cs[3]); o2[q] = pk_bf16(b0 * cs[0] + a0 * cs[1], b1 * cs[2] + a1 * cs[3]); }
                    *(u32x4*)(dst + 8 * c8) = o1; *(u32x4*)(dst + 64 + 8 * c8) = o2;
                }
                for (int i = gtid; i < M * 4 * 16; i += NGT) {
                    const int cc = i & 15, gg = (i >> 4) & 1, kv = (i >> 5) & 1, m = i >> 6, b = m >> 11, t = m & (T - 1);
                    *(u32x4*)(CMPIN + ((size_t)kv * 8 + b * 2 + gg) * T * 128 + (size_t)t * 128 + 8 * cc) = *(const u32x4*)(PBUF + (size_t)m * HYBN + 1024 + kv * 256 + gg * 128 + 8 * cc);
                }
                if (gw < 32) {
                    const int b = gw >> 3, h = gw & 7; const float fb = a.in[13][h]; float v[32]; float s = 0.f;
#pragma unroll
                    for (int i = 0; i < 32; ++i) { const float z = bf2f(PBUF[((size_t)b * T + 32 * lane + i) * HYBN + 5656 + h]) + fb; const float lf = fminf(z, 0.f) - log1pf(__expf(-fabsf(z))); s += lf; v[i] = s; }
                    float incl = s;
#pragma unroll
                    for (int o = 1; o < 64; o <<= 1) { const float n = __shfl_up(incl, o); if (lane >= o) incl += n; }
                    const float excl = incl - s;
#pragma unroll
                    for (int i = 0; i < 32; ++i) CUM2[((size_t)b * T + 32 * lane + i) * 8 + h] = (excl + v[i]) * LOG2E;
                }
                if (gtid < 512) { float s = 0.f; for (int i = 0; i < 64; ++i) s += BPART[i * 512 + gtid]; BIASPE[gtid] = s; }
            }
            GSYNC();
            {
                pg8::Gemm g{CMPIN, CMPIN + (size_t)8 * T * 128, CMPW1, 1024, 512, 4096, 2048, 1};
                pg8::ListOrder S; S.init(1024, 512, G, bid);
                pg8::EpiGelu E{HID, BIASPE};
                pg8::gemm_phase<pg8::EpiGelu, pg8::ListOrder, true, true>(lds, g, S, E);
                AttnArgs af{}; af.Q = PBUF + 2560; af.ldq = HYBN; af.qhs = 128; af.K = PBUF + 3584; af.ldk = HYBN; af.khs = 128; af.K2 = nullptr; af.ldk2 = 0; af.V = PBUF + 4608; af.ldv = HYBN; af.vhs = 128;
                af.O = OBUF; af.ldo = 2048; af.ocol0 = 1024; af.sc2 = 0.08838834764831845f * LOG2E; af.CUM2 = CUM2; af.SEL = SEL; af.P = PBUF; af.OCMP = OCMP; af.OWIN = OWIN;
                AttnArgs aw = af; aw.Q = QR; aw.ldq = 1024; aw.K = PBUF + 2048; aw.V = PBUF + 2304; aw.O = OWIN; aw.ldo = 1024; aw.ocol0 = 0;
                for (int arep = 0; arep < 1 + PROBE_ATTX2; ++arep) for (;;) {
                    const int u = fetch_unit(ctl + 64 * (1 + 8 * arep), slot);
                    if (u >= 512) break;
                    if (u < 256) { const int qb = 7 - (u >> 5), bh = u & 31; attn_unit<1, 128, 1>(lds, af, bh >> 3, bh & 7, qb); }
                    else { const int v = u - 256, qb = v >> 3, bg = v & 7; attn_unit<2, 128, 4>(lds, aw, bg >> 1, bg & 1, qb); }
                }
            }
            GSYNC();
            {
                int tid_o = threadIdx.x; asm volatile("" : "+v"(tid_o)); const int tid = tid_o, lane = tid & 63, wave = __builtin_amdgcn_readfirstlane(tid >> 6), gw = bid * 8 + wave, gtid = bid * 512 + tid; (void)lane; (void)gw; (void)gtid;
                for (int i = gtid; i < 2 * 256 * 128 * 2; i += NGT) {
                    const int ch = i & 1, d = (i >> 1) & 127, rg = (i >> 8) & 255, kv = i >> 16;
                    const bf16_t* hp = HID + ((size_t)kv * 1024 + 4 * rg) * 256 + 128 * ch; const float* wp = a.in[12] + (size_t)kv * 256 * 128 + (size_t)(128 * ch) * 128 + d;
                    float s0 = 0.f, s1 = 0.f, s2 = 0.f, s3 = 0.f;
#pragma unroll 2
                    for (int c8 = 0; c8 < 16; ++c8) {
                        const u32x4 h0 = *(const u32x4*)(hp + 8 * c8), h1 = *(const u32x4*)(hp + 256 + 8 * c8), h2 = *(const u32x4*)(hp + 512 + 8 * c8), h3 = *(const u32x4*)(hp + 768 + 8 * c8);
#pragma unroll
                        for (int q = 0; q < 4; ++q) { const float w0 = wp[(size_t)(8 * c8 + 2 * q) * 128], w1 = wp[(size_t)(8 * c8 + 2 * q + 1) * 128];
                            s0 += bf_lo(h0[q]) * w0 + bf_hi(h0[q]) * w1; s1 += bf_lo(h1[q]) * w0 + bf_hi(h1[q]) * w1; s2 += bf_lo(h2[q]) * w0 + bf_hi(h2[q]) * w1; s3 += bf_lo(h3[q]) * w0 + bf_hi(h3[q]) * w1; }
                    }
                    s0 += __shfl_xor(s0, 1); s1 += __shfl_xor(s1, 1); s2 += __shfl_xor(s2, 1); s3 += __shfl_xor(s3, 1);
                    if (ch == 0) { bf16_t* kp = KCVC + ((size_t)kv * 1024 + 4 * rg) * 128 + d;
                        if ((rg & 31) == 31) s3 = 0.f;
                        kp[0] = (bf16_t)(pk_bf16(s0, 0.f) & 0xffffu); kp[128] = (bf16_t)(pk_bf16(s1, 0.f) & 0xffffu); kp[256] = (bf16_t)(pk_bf16(s2, 0.f) & 0xffffu); kp[384] = (bf16_t)(pk_bf16(s3, 0.f) & 0xffffu); }
                }
            }
            GSYNC();
            {
                for (int arep = 0; arep < 1 + PROBE_ATTX2; ++arep) for (;;) {
                    const int u = fetch_unit(ctl + 64 * (2 + 8 * arep), slot);
                    if (u >= 256) break;
                    const int qb = 31 - (u >> 3), bg = u & 7;
                    cmp_unit(lds, PBUF, KCVC, KCVC + (size_t)1024 * 128, OCMP, SEL, bg >> 1, bg & 1, qb);
                }
            }
            GSYNC();
            {
                AttnArgs as{}; as.Q = QR; as.ldq = 1024; as.qhs = 128; as.K = PBUF + 1536; as.ldk = HYBN; as.khs = 128; as.K2 = nullptr; as.ldk2 = 0; as.V = PBUF + 1792; as.ldv = HYBN; as.vhs = 128;
                as.O = OBUF; as.ldo = 2048; as.ocol0 = 0; as.sc2 = 0.08838834764831845f * LOG2E; as.CUM2 = CUM2; as.SEL = SEL; as.P = PBUF; as.OCMP = OCMP; as.OWIN = OWIN;
                for (int arep = 0; arep < 1 + PROBE_ATTX2; ++arep) for (;;) {
                    const int u = fetch_unit(ctl + 64 * (3 + 8 * arep), slot);
                    if (u >= 256) break;
                    const int qb = 31 - (u >> 3), bg = u & 7;
                    attn_unit<3, 128, 4>(lds, as, bg >> 1, bg & 1, qb);
                }
            }
            GSYNC();
        }
        if (k == 2) {
            {
                pg8::Gemm g{XB, XB, MLAIN, M, MLAN, 2048, 2048, 1 << 30};
                pg8::StaticOrder S; S.init(M, MLAN, G, bid);
                pg8::EpiScale<8, true> E{CB, MLAN, CB, MLAN, 1 << 30, SSQ, 0, 0, 1.f / 2048.f, SSQ2};
                pg8::gemm_phase<pg8::EpiScale<8, true>, pg8::StaticOrder, true, true>(lds, g, S, E);
            }
            if (bid >= 160 && G == 256) {
                int tid_o = threadIdx.x; asm volatile("" : "+v"(tid_o)); const int lane = tid_o & 63, wave = __builtin_amdgcn_readfirstlane(tid_o >> 6);
                LAS float* scr = (LAS float*)(lds + wave * 16384);
                TJOBR(1, a.in[6] + (size_t)2048 * 11264, 2048, 11264, 11264, a.in[5] + 2048, (bf16_t*)(ws + WS_W1T + (size_t)3 * 44 * MiB), (bid - 160) * 8 + wave, 96 * 8, 1728, 9088);
            } else if (G != 256) {
                int tid_o = threadIdx.x; asm volatile("" : "+v"(tid_o)); const int lane = tid_o & 63, wave = __builtin_amdgcn_readfirstlane(tid_o >> 6);
                LAS float* scr = (LAS float*)(lds + wave * 16384);
                TJOBR(1, a.in[6] + (size_t)2048 * 11264, 2048, 11264, 11264, a.in[5] + 2048, (bf16_t*)(ws + WS_W1T + (size_t)3 * 44 * MiB), bid * 8 + wave, G * 8, 1728, 9088);
            }
            GSYNC();
            {
                pg8::Gemm g{CB, CB + 512, UQKV, M, 7168, 512, MLAN, 12};
                pg8::StaticOrder S; S.init(M, 7168, G, bid);
                pg8::EpiScale<2, false> E{QBUF, 3072, KVBUF, 4096, 12, SSQ2, 0, 8, 1.f / 512.f, nullptr};
                pg8::gemm_phase<pg8::EpiScale<2, false>, pg8::StaticOrder, true, true>(lds, g, S, E);
            }
            GSYNC();
            {
                int tid_o = threadIdx.x; asm volatile("" : "+v"(tid_o)); const int tid = tid_o, lane = tid & 63, wave = __builtin_amdgcn_readfirstlane(tid >> 6), gw = bid * 8 + wave, gtid = bid * 512 + tid; (void)lane; (void)gw; (void)gtid;
                for (int i = gtid; i < M * 17 * 4; i += NGT) {
                    const int c = i & 3, u = (i >> 2) % 17, m = i / 68, t = m & (T - 1);
                    bf16_t* p = (u < 16) ? QBUF + (size_t)m * 3072 + u * 192 + 128 : CB + (size_t)m * MLAN + 1024;
                    const u32x4 x1 = *(const u32x4*)(p + 8 * c), x2 = *(const u32x4*)(p + 32 + 8 * c);
                    const f32x4* csp = (const f32x4*)(ROPE64 + ((size_t)t * 32 + 8 * c) * 2);
                    u32x4 o1, o2;
#pragma unroll
                    for (int q = 0; q < 4; ++q) { const f32x4 cs = csp[q]; const float a0 = bf_lo(x1[q]), a1 = bf_hi(x1[q]), b0 = bf_lo(x2[q]), b1 = bf_hi(x2[q]);
                        o1[q] = pk_bf16(a0 * cs[0] - b0 * cs[1], a1 * cs[2] - b1 * cs[3]); o2[q] = pk_bf16(b0 * cs[0] + a0 * cs[1], b1 * cs[2] + a1 * cs[3]); }
                    *(u32x4*)(p + 8 * c) = o1; *(u32x4*)(p + 32 + 8 * c) = o2;
                }
            }
            GSYNC();
            {
                AttnArgs am{}; am.Q = QBUF; am.ldq = 3072; am.qhs = 192; am.K = KVBUF; am.ldk = 4096; am.khs = 256; am.K2 = CB + 1024; am.ldk2 = MLAN; am.V = KVBUF + 128; am.ldv = 4096; am.vhs = 256;
                am.O = OBUF; am.ldo = 2048; am.ocol0 = 0; am.sc2 = 0.07216878364870322f * LOG2E; am.CUM2 = CUM2; am.SEL = SEL; am.P = PBUF; am.OCMP = OCMP; am.OWIN = OWIN;
                for (int arep = 0; arep < 1 + PROBE_ATTX2; ++arep) for (;;) {
                    const int u = fetch_unit(ctl + 64 * (4 + 8 * arep), slot);
                    if (u >= 512) break;
                    const int qb = 7 - (u >> 6), bh = u & 63;
                    attn_unit<0, 192, 1>(lds, am, bh >> 4, bh & 15, qb);
                }
            }
            GSYNC();
        }
        if (k == 0 || k == 2) {
            pg8::Gemm g{OBUF, OBUF, k == 0 ? HYBOUT : MLAOUT, M, 2048, 2048, 2048, 1 << 30};
            pg8::StaticOrder S; S.init(M, 2048, G, bid);
            pg8::EpiResid E{X, X, XB, SSQ, 1.0f};
            pg8::gemm_phase<pg8::EpiResid, pg8::StaticOrder, true, true>(lds, g, S, E);
            GSYNC();
        }
    }
    {
                int tid_o = threadIdx.x; asm volatile("" : "+v"(tid_o)); const int tid = tid_o, lane = tid & 63, wave = __builtin_amdgcn_readfirstlane(tid >> 6), gw = bid * 8 + wave, gtid = bid * 512 + tid; (void)lane; (void)gw; (void)gtid;
    for (int m = gw; m < M; m += NGW) {
        float s = (lane < 32) ? SSQ[(size_t)m * 32 + lane] : 0.f; s = wave_sum(s);
        const float rs = rsqrtf(s * (1.f / 2048.f) + pg8::NORM_EPS);
        f32x4* xr = (f32x4*)(X + (size_t)m * D) + lane; const f32x4* gr = (const f32x4*)a.in[20] + lane;
#pragma unroll
        for (int j = 0; j < 8; ++j) { f32x4 v = xr[64 * j]; const f32x4 g4 = gr[64 * j]; v = v * rs * g4; xr[64 * j] = v; }
    }
    }
}

extern "C" void kernel_launch(void* const* d_in, const int* in_sizes, int n_in, void* d_out, int out_size, void* d_ws, size_t ws_size, hipStream_t stream) {
    static int grid = 0;
    if (grid == 0) {
        if (n_in != 21 || ws_size < WS_END) { fprintf(stderr, "kernel_launch: unexpected n_in %d or ws %zu (< %zu)\n", n_in, ws_size, (size_t)WS_END); grid = -1; return; }
        int dev = 0, cus = 0, per_cu = 0;
        hipGetDevice(&dev); hipDeviceGetAttribute(&cus, hipDeviceAttributeMultiprocessorCount, dev);
        if (hipFuncSetAttribute((const void*)mega_fwd, hipFuncAttributeMaxDynamicSharedMemorySize, LDS_BYTES) != hipSuccess) { fprintf(stderr, "hipFuncSetAttribute failed\n"); grid = -1; return; }
        if (hipOccupancyMaxActiveBlocksPerMultiprocessor(&per_cu, (const void*)mega_fwd, 512, LDS_BYTES) != hipSuccess || per_cu < 1) { fprintf(stderr, "occupancy query: %d\n", per_cu); per_cu = 1; }
        (void)hipGetLastError();
        grid = cus * 1;
    }
    if (grid < 0) return;
    Args a{};
    for (int i = 0; i < 21; ++i) a.in[i] = (const float*)d_in[i];
    a.out = (float*)d_out; a.ws = (unsigned char*)d_ws;
    void* args[] = {&a};
    hipError_t e = hipLaunchCooperativeKernel((const void*)mega_fwd, dim3(grid), dim3(512), args, LDS_BYTES, stream);
    if (e != hipSuccess) fprintf(stderr, "cooperative launch failed: %s (grid %d)\n", hipGetErrorString(e), grid);
}
```

```cpp
#include <hip/hip_runtime.h>
#include <hip/hip_cooperative_groups.h>
#include <cstdio>
#include <cstdint>
namespace cg = cooperative_groups;
#ifndef PROBE_SYNC2
#define PROBE_SYNC2 0
#endif
#ifndef PROBE_TSMASK
#define PROBE_TSMASK 0u
#endif
#ifndef PROBE_UPX2
#define PROBE_UPX2 0
#endif
#ifndef PROBE_ATTX2
#define PROBE_ATTX2 0
#endif
#ifndef PROBE_P0X2
#define PROBE_P0X2 0
#endif
#define GSYNC() do { xcd_barrier(xbar); if (PROBE_SYNC2) xcd_barrier(xbar); if (PROBE_TSMASK) { ++ts_idx; if (blockIdx.x == 0 && threadIdx.x == 0) ((unsigned long long*)(a.ws + 65536))[ts_idx] = __builtin_amdgcn_s_memrealtime(); } } while (0)
namespace pg8 {
#define PG8_LAS __attribute__((address_space(3)))
typedef unsigned short bf16_t;
typedef short bf16x8 __attribute__((ext_vector_type(8)));
typedef float f32x4 __attribute__((ext_vector_type(4)));
typedef unsigned u32x4 __attribute__((ext_vector_type(4)));
constexpr int BM = 256, BK = 64, HALF = 128, HTB = HALF * BK * 2  , STAGE_BYTES = 8 * HTB, NXCD = 8, WGM = 8;

__host__ __device__ __forceinline__ int lds_byte(int r, int c) { const int st = (r >> 4) * 2 + (c >> 5), rr = r & 15, cc = c & 31, ob = rr * 64 + cc * 2; return st * 1024 + (ob ^ (((ob >> 9) & 1) << 5)); }
__host__ __device__ __forceinline__ void stage_rc(int b, int& R, int& C) { const int st = b / 1024, sb = b % 1024, swz = sb ^ (((sb >> 9) & 1) << 5); R = (st >> 1) * 16 + swz / 64; C = (st & 1) * 32 + (swz % 64) / 2; }
__host__ __device__ __forceinline__ int perm32(int rho) { const int n = rho >> 4, i = rho & 15; return 8 * (i >> 2) + 4 * n + (i & 3); }

struct Unit { int pm, pn; };

struct StaticOrder {
    int nM, nN, nwg, G, c;
    __host__ __device__ void init(int M, int N, int G_, int c_) { nM = M / BM; nN = N / BM; nwg = nM * nN; G = G_; c = c_; }
    __host__ __device__ bool next(int i, Unit& u) const {
        const long L = (long)i * G + c; if (L >= nwg) return false;
        int wgid = (int)L; { const int q = nwg / NXCD, r = nwg % NXCD, xcd = wgid % NXCD, off = wgid / NXCD; wgid = (xcd < r ? xcd * (q + 1) : r * (q + 1) + (xcd - r) * q) + off; }
        const int nig = WGM * nN, gid = wgid / nig, fm = gid * WGM, gsz = (nM - fm) < WGM ? (nM - fm) : WGM;
        u.pm = fm + ((wgid % nig) % gsz); u.pn = (wgid % nig) / gsz; return true;
    }
    __device__ __forceinline__ void a_ready(const Unit&) const {}
    __device__ __forceinline__ void done(const Unit&) const {}
};

struct Gemm { const bf16_t* A; const bf16_t* A2; const bf16_t* Bt; int M, N, K, lda, pn2; };
struct ListOrder {
    int nM, nwg, G, c;
    __device__ void init(int M, int N, int G_, int c_) { nM = M / BM; nwg = nM * (N / BM); G = G_; c = c_; }
    __device__ bool next(int i, Unit& u) const { const long L = (long)i * G + c; if (L >= nwg) return false; u.pm = (int)L % nM; u.pn = (int)L / nM; return true; }
    __device__ __forceinline__ void a_ready(const Unit&) const {}
    __device__ __forceinline__ void done(const Unit&) const {}
};
typedef __bf16 bf16x2v __attribute__((ext_vector_type(2)));
typedef float f32x2v __attribute__((ext_vector_type(2)));
typedef unsigned u32x2 __attribute__((ext_vector_type(2)));
__device__ __forceinline__ unsigned pk_bf16(float lo, float hi) { f32x2v f = {lo, hi}; return __builtin_bit_cast(unsigned, __builtin_convertvector(f, bf16x2v)); }
__device__ __forceinline__ float bf_lo(unsigned u) { return __uint_as_float(u << 16); }
__device__ __forceinline__ float bf_hi(unsigned u) { return __uint_as_float(u & 0xffff0000u); }
__device__ __forceinline__ float bf2f(bf16_t v) { return __uint_as_float(((unsigned)v) << 16); }

constexpr float NORM_EPS = 1e-6f;
template <int PER> __device__ __forceinline__ float row_rstd(const float* ssq, int off, float invn, int row, int fq) {
    const float* p = ssq + (size_t)row * 32 + off + fq * PER; float s = 0.f;
#pragma unroll
    for (int i = 0; i < PER; ++i) s += p[i];
    s += __shfl_xor(s, 16); s += __shfl_xor(s, 32);
    return rsqrtf(s * invn + NORM_EPS);
}
__device__ __forceinline__ float silu_f(float g) { return g * __builtin_amdgcn_rcpf(1.f + __expf(-g)); }
__device__ __forceinline__ float gelu_tanh_f(float x) { const float u = 0.7978845608028654f * (x + 0.044715f * x * x * x); const float e = __expf(2.f * u); const float th = 1.f - 2.f * __builtin_amdgcn_rcpf(1.f + e); return 0.5f * x * (1.f + th); }

struct EpiSwiglu {
    static constexpr bool PERM = true, AFTER_DRAIN = false;
    bf16_t* O; int ldc; const float* ssq;
    __device__ __forceinline__ void operator()(const f32x4 (&acc)[2][2][4][2], const Unit& u, int wr, int wc, int fr, int fq) const {
        const int row0 = u.pm * BM + wr * 64 + fr, col0 = u.pn * 128 + wc * 32 + 8 * fq;
        float rsv[2][4];
#pragma unroll
        for (int ai = 0; ai < 2; ++ai)
#pragma unroll
            for (int m = 0; m < 4; ++m) rsv[ai][m] = row_rstd<8>(ssq, 0, 1.f / 2048.f, row0 + ai * HALF + m * 16, fq);
#pragma unroll
        for (int ai = 0; ai < 2; ++ai)
#pragma unroll
            for (int m = 0; m < 4; ++m) {
                const int row = row0 + ai * HALF + m * 16; const float rs = rsv[ai][m];
                f32x4 v0, v1;
#pragma unroll
                for (int j = 0; j < 4; ++j) { v0[j] = silu_f(acc[ai][0][m][0][j] * rs) * (acc[ai][1][m][0][j] * rs); v1[j] = silu_f(acc[ai][0][m][1][j] * rs) * (acc[ai][1][m][1][j] * rs); }
                u32x4 w; w.x = pk_bf16(v0[0], v0[1]); w.y = pk_bf16(v0[2], v0[3]); w.z = pk_bf16(v1[0], v1[1]); w.w = pk_bf16(v1[2], v1[3]);
                *(u32x4*)(O + (size_t)row * ldc + col0) = w;
            }
    }
};
template <int PER, bool SSQ_OUT, int ROPE = 0> struct EpiScale {
    static constexpr bool PERM = true, AFTER_DRAIN = false;
    bf16_t* O; int ldc; bf16_t* O2; int ldc2; int pn2; const float* ssq; int soff, soff2; float invn; float* ssq_out; const float* rope;
    __device__ __forceinline__ void operator()(const f32x4 (&acc)[2][2][4][2], const Unit& u, int wr, int wc, int fr, int fq) const {
        const int row0 = u.pm * BM + wr * 64 + fr; const bool second = u.pn >= pn2;
        bf16_t* base = second ? O2 : O; const int ld = second ? ldc2 : ldc; const int so = second ? soff2 : soff;
        const int col0 = (second ? u.pn - pn2 : u.pn) * BM + wc * 32 + 8 * fq;
        float rsv[2][4];
#pragma unroll
        for (int ai = 0; ai < 2; ++ai)
#pragma unroll
            for (int m = 0; m < 4; ++m) rsv[ai][m] = row_rstd<PER>(ssq, so, invn, row0 + ai * HALF + m * 16, fq);
#pragma unroll
        for (int ai = 0; ai < 2; ++ai)
#pragma unroll
            for (int m = 0; m < 4; ++m) {
                const int row = row0 + ai * HALF + m * 16; const float rs = rsv[ai][m];
                float sq = 0.f;
#pragma unroll
                for (int bj = 0; bj < 2; ++bj) { f32x4 v0 = acc[ai][bj][m][0] * rs, v1 = acc[ai][bj][m][1] * rs;
                    if (ROPE != 0) { const int cc = col0 + bj * HALF; int i0 = -1;
                        if (ROPE == 1) { if (!second) { const int c192 = cc % 192; if (c192 >= 128) i0 = (c192 - 128) >> 1; } }
                        else { if (cc >= 1024 && cc < 1088) i0 = (cc - 1024) >> 1; }
                        if (i0 >= 0) { const float* rp = rope + ((size_t)(row & 2047) * 32 + i0) * 2; const f32x4 c0 = *(const f32x4*)rp, c1 = *(const f32x4*)(rp + 4);
                            const f32x4 a0 = v0, a1 = v1;
                            v0[0] = a0[0] * c0[0] - a0[1] * c0[1]; v0[1] = a0[1] * c0[0] + a0[0] * c0[1]; v0[2] = a0[2] * c0[2] - a0[3] * c0[3]; v0[3] = a0[3] * c0[2] + a0[2] * c0[3];
                            v1[0] = a1[0] * c1[0] - a1[1] * c1[1]; v1[1] = a1[1] * c1[0] + a1[0] * c1[1]; v1[2] = a1[2] * c1[2] - a1[3] * c1[3]; v1[3] = a1[3] * c1[2] + a1[2] * c1[3]; } }
                    if (SSQ_OUT) sq += (v0[0] * v0[0] + v0[1] * v0[1]) + (v0[2] * v0[2] + v0[3] * v0[3]) + (v1[0] * v1[0] + v1[1] * v1[1]) + (v1[2] * v1[2] + v1[3] * v1[3]);
                    u32x4 w; w.x = pk_bf16(v0[0], v0[1]); w.y = pk_bf16(v0[2], v0[3]); w.z = pk_bf16(v1[0], v1[1]); w.w = pk_bf16(v1[2], v1[3]);
                    *(u32x4*)(base + (size_t)row * ld + col0 + bj * HALF) = w; }
                if (SSQ_OUT) { sq += __shfl_xor(sq, 16); sq += __shfl_xor(sq, 32); if (fq == 0) ssq_out[(size_t)row * 32 + u.pn * 4 + wc] = sq; }
            }
    }
};
struct EpiResid {
    static constexpr bool PERM = false, AFTER_DRAIN = false;
    const float* base; float* out; bf16_t* xb; float* ssq; float c;
    __device__ __forceinline__ void operator()(const f32x4 (&acc)[2][2][4][2], const Unit& u, int wr, int wc, int fr, int fq) const {
        const int row0 = u.pm * BM + wr * 64 + fr, col0 = u.pn * BM + wc * 32 + 4 * fq;
        f32x4 bv[8][2][2];
#define RES_LD(g) do { const size_t ro_ = (size_t)(row0 + ((g) >> 2) * HALF + ((g) & 3) * 16) * 2048 + col0; \
        _Pragma("unroll") for (int bj = 0; bj < 2; ++bj) _Pragma("unroll") for (int n = 0; n < 2; ++n) bv[g][bj][n] = *(const f32x4*)(base + ro_ + bj * HALF + n * 16); } while (0)
        RES_LD(0); RES_LD(1); RES_LD(2);
#pragma unroll
        for (int g = 0; g < 8; ++g) {
            const int ai = g >> 2, m = g & 3; const int row = row0 + ai * HALF + m * 16; float sq = 0.f;
#pragma unroll
            for (int bj = 0; bj < 2; ++bj)
#pragma unroll
                for (int n = 0; n < 2; ++n) { const size_t off = (size_t)row * 2048 + col0 + bj * HALF + n * 16;
                    const f32x4 v = bv[g][bj][n] + acc[ai][bj][m][n] * c;
                    *(f32x4*)(out + off) = v; sq += (v[0] * v[0] + v[1] * v[1]) + (v[2] * v[2] + v[3] * v[3]);
                    u32x2 w; w.x = pk_bf16(v[0], v[1]); w.y = pk_bf16(v[2], v[3]); *(u32x2*)(xb + off) = w; }
            sq += __shfl_xor(sq, 16); sq += __shfl_xor(sq, 32); if (fq == 0) ssq[(size_t)row * 32 + u.pn * 4 + wc] = sq;
            if (g + 3 < 8) { switch (g + 3) { case 3: RES_LD(3); break; case 4: RES_LD(4); break; case 5: RES_LD(5); break; case 6: RES_LD(6); break; default: RES_LD(7); break; } }
        }
#undef RES_LD
    }
};
struct EpiGelu {
    static constexpr bool PERM = true, AFTER_DRAIN = false;
    bf16_t* HID; const float* bias;
    __device__ __forceinline__ void operator()(const f32x4 (&acc)[2][2][4][2], const Unit& u, int wr, int wc, int fr, int fq) const {
        const int row0 = u.pm * BM + wr * 64 + fr, col0 = wc * 32 + 8 * fq;
        f32x4 bb[2][2];
#pragma unroll
        for (int bj = 0; bj < 2; ++bj) { const float* bp = bias + u.pn * 256 + col0 + bj * HALF; bb[bj][0] = *(const f32x4*)bp; bb[bj][1] = *(const f32x4*)(bp + 4); }
#pragma unroll
        for (int ai = 0; ai < 2; ++ai)
#pragma unroll
            for (int m = 0; m < 4; ++m) { const int row = row0 + ai * HALF + m * 16;
#pragma unroll
                for (int bj = 0; bj < 2; ++bj) { float v[8];
#pragma unroll
                    for (int j = 0; j < 4; ++j) { v[j] = gelu_tanh_f(acc[ai][bj][m][0][j] + bb[bj][0][j]); v[4 + j] = gelu_tanh_f(acc[ai][bj][m][1][j] + bb[bj][1][j]); }
                    u32x4 w; w.x = pk_bf16(v[0], v[1]); w.y = pk_bf16(v[2], v[3]); w.z = pk_bf16(v[4], v[5]); w.w = pk_bf16(v[6], v[7]);
                    *(u32x4*)(HID + ((size_t)u.pn * 1024 + row) * 256 + col0 + bj * HALF) = w; } }
    }
};
template <class Epi, class Sched, bool ALIGN_EPI = false, bool SP2 = false>
__device__ __forceinline__ void gemm_phase(PG8_LAS unsigned char* lds, const Gemm g, const Sched& S, const Epi& E) {
    int tid_op = threadIdx.x; asm volatile("" : "+v"(tid_op));
    const int tid = tid_op, wid = __builtin_amdgcn_readfirstlane(tid >> 6), lane = tid & 63, wr = wid >> 2, wc = wid & 3, fr = lane & 15, fq = lane >> 4;
    const int K = g.K, nt = K / BK;
    unsigned voffA[2], voffB[2];
#pragma unroll
    for (int i = 0; i < 2; ++i) { int R, C; stage_rc(tid * 16 + i * 8192, R, C); const int Rb = Epi::PERM ? ((R & ~31) + perm32(R & 31)) : R;
        voffA[i] = (unsigned)(R * g.lda + C) * 2u; voffB[i] = (unsigned)(Rb * K + C) * 2u; }
    const size_t kstep = (size_t)(BK * 2);
    const size_t hstepB = (size_t)HALF * K * 2, hstepA = (size_t)HALF * g.lda * 2;
    const size_t tstepA = 2 * hstepA, tstepB = 2 * hstepB;
    const unsigned ldsw = (unsigned)wid * 1024u;
    const int aoff = lds_byte(wr * 64 + fr, fq * 8), boff = lds_byte(wc * 32 + fr, fq * 8);
#define PG8_SA(b, h) (((b) * 2 + (h)) * HTB)
#define PG8_SB(b, h) ((4 + (b) * 2 + (h)) * HTB)
#define PG8_STAGE(bufoff, gbase, voff) do { _Pragma("unroll") for (int _i = 0; _i < 2; ++_i) \
        __builtin_amdgcn_global_load_lds((const unsigned*)((const char*)(gbase) + (voff)[_i]), (PG8_LAS unsigned*)(lds + (bufoff) + ldsw + _i * 8192), 16, 0, 0); } while (0)
#define PG8_LDA(dst, b, h) do { _Pragma("unroll") for (int m = 0; m < 4; ++m) _Pragma("unroll") for (int k = 0; k < 2; ++k) dst[m][k] = *(const PG8_LAS bf16x8*)(lds + PG8_SA(b, h) + aoff + m * 2048 + k * 1024); } while (0)
#define PG8_LDB(dst, b, h) do { _Pragma("unroll") for (int n = 0; n < 2; ++n) _Pragma("unroll") for (int k = 0; k < 2; ++k) dst[n][k] = *(const PG8_LAS bf16x8*)(lds + PG8_SB(b, h) + boff + n * 2048 + k * 1024); } while (0)
#define PG8_MMA(ai, bj, At, Bt) do { __builtin_amdgcn_s_setprio(1); _Pragma("unroll") for (int m = 0; m < 4; ++m) _Pragma("unroll") for (int n = 0; n < 2; ++n) _Pragma("unroll") for (int k = 0; k < 2; ++k) \
        acc[ai][bj][m][n] = __builtin_amdgcn_mfma_f32_16x16x32_bf16(Bt[n][k], At[m][k], acc[ai][bj][m][n], 0, 0, 0); __builtin_amdgcn_s_setprio(0); } while (0)
#define PG8_WAIT_V(n) asm volatile("s_waitcnt vmcnt(" #n ")" ::: "memory")
#define PG8_WAIT_L(n) asm volatile("s_waitcnt lgkmcnt(" #n ")" ::: "memory")
#define PG8_BAR __builtin_amdgcn_s_barrier()
#define PG8_SCHED __builtin_amdgcn_sched_barrier(0)
    Unit cur, nxt; int ui = 0;
    if (!S.next(0, cur)) return;
    f32x4 acc[2][2][4][2];
#pragma unroll
    for (int a = 0; a < 2; ++a)
#pragma unroll
        for (int b = 0; b < 2; ++b)
#pragma unroll
            for (int m = 0; m < 4; ++m)
#pragma unroll
                for (int n = 0; n < 2; ++n) acc[a][b][m][n] = (f32x4){0.f, 0.f, 0.f, 0.f};
    bf16x8 At[4][2], B0[2][2], B1[2][2];
    const char* cA = (const char*)(cur.pn >= g.pn2 ? g.A2 : g.A) + (size_t)cur.pm * tstepA; const char* cB = (const char*)g.Bt + (size_t)cur.pn * tstepB;
    S.a_ready(cur);
    if constexpr (SP2) {
        PG8_STAGE(PG8_SB(0, 0), cB, voffB); PG8_STAGE(PG8_SB(0, 1), cB + hstepB, voffB); PG8_STAGE(PG8_SA(0, 0), cA, voffA); PG8_STAGE(PG8_SA(0, 1), cA + hstepA, voffA);
        if (wr == 1) PG8_BAR;
        PG8_WAIT_V(2); PG8_BAR;
        PG8_STAGE(PG8_SB(1, 0), cB + kstep, voffB); PG8_STAGE(PG8_SA(1, 0), cA + kstep, voffA); PG8_STAGE(PG8_SB(1, 1), cB + hstepB + kstep, voffB);
        PG8_WAIT_V(6); PG8_BAR;
    } else {
        PG8_STAGE(PG8_SB(0, 0), cB, voffB); PG8_STAGE(PG8_SA(0, 0), cA, voffA); PG8_STAGE(PG8_SB(0, 1), cB + hstepB, voffB); PG8_STAGE(PG8_SA(0, 1), cA + hstepA, voffA);
        if (wr == 1) PG8_BAR;
        PG8_WAIT_V(4); PG8_BAR;
        PG8_STAGE(PG8_SB(1, 0), cB + kstep, voffB); PG8_STAGE(PG8_SA(1, 0), cA + kstep, voffA); PG8_STAGE(PG8_SB(1, 1), cB + hstepB + kstep, voffB);
        PG8_WAIT_V(6); PG8_BAR;
    }
    for (;;) {
        const bool has_next = S.next(ui + 1, nxt);
        const char* nA = has_next ? (const char*)(nxt.pn >= g.pn2 ? g.A2 : g.A) + (size_t)nxt.pm * tstepA : cA; const char* nB = has_next ? (const char*)g.Bt + (size_t)nxt.pn * tstepB : cB;
        for (int t = 0; t < nt; t += 2) {
            const bool last = (t == nt - 2);
            const char* a1 = cA + (size_t)(t + 1) * kstep;
            const char* a2 = last ? nA : cA + (size_t)(t + 2) * kstep; const char* b2 = last ? nB : cB + (size_t)(t + 2) * kstep;
            const char* a3 = a2 + kstep; const char* b3 = b2 + kstep;
            if (last && has_next) S.a_ready(nxt);
            if constexpr (SP2) {
            PG8_LDB(B0, 0, 0); PG8_LDB(B1, 0, 1); PG8_SCHED; PG8_LDA(At, 0, 0); PG8_STAGE(PG8_SA(1, 1), a1 + hstepA, voffA);
            PG8_WAIT_V(8); PG8_WAIT_L(0); PG8_BAR; PG8_MMA(0, 0, At, B0); PG8_MMA(0, 1, At, B1); PG8_BAR; PG8_SCHED;
            PG8_LDA(At, 0, 1); PG8_STAGE(PG8_SB(0, 0), b2, voffB); PG8_STAGE(PG8_SB(0, 1), b2 + hstepB, voffB); PG8_STAGE(PG8_SA(0, 0), a2, voffA);
            PG8_WAIT_V(8); PG8_WAIT_L(0); PG8_BAR; PG8_MMA(1, 0, At, B0); PG8_MMA(1, 1, At, B1); PG8_BAR; PG8_SCHED;
            PG8_LDB(B0, 1, 0); PG8_LDB(B1, 1, 1); PG8_SCHED; PG8_LDA(At, 1, 0); PG8_STAGE(PG8_SA(0, 1), a2 + hstepA, voffA);
            PG8_WAIT_V(8); PG8_WAIT_L(0); PG8_BAR; PG8_MMA(0, 0, At, B0); PG8_MMA(0, 1, At, B1); PG8_BAR; PG8_SCHED;
            PG8_LDA(At, 1, 1); PG8_STAGE(PG8_SB(1, 0), b3, voffB); PG8_STAGE(PG8_SB(1, 1), b3 + hstepB, voffB); PG8_STAGE(PG8_SA(1, 0), a3, voffA);
            PG8_WAIT_V(8); PG8_WAIT_L(0); PG8_BAR; PG8_MMA(1, 0, At, B0); PG8_MMA(1, 1, At, B1); PG8_BAR; PG8_SCHED;
            } else {
            PG8_LDB(B0, 0, 0); PG8_SCHED; PG8_LDA(At, 0, 0); PG8_STAGE(PG8_SA(1, 1), a1 + hstepA, voffA);
            PG8_WAIT_L(8); PG8_BAR; PG8_WAIT_L(0); PG8_MMA(0, 0, At, B0); PG8_BAR; PG8_SCHED;
            PG8_LDB(B1, 0, 1); PG8_STAGE(PG8_SB(0, 0), b2, voffB);
            PG8_BAR; PG8_WAIT_L(0); PG8_MMA(0, 1, At, B1); PG8_BAR;
            PG8_LDA(At, 0, 1); PG8_STAGE(PG8_SA(0, 0), a2, voffA);
            PG8_BAR; PG8_WAIT_L(0); PG8_MMA(1, 0, At, B0); PG8_BAR; PG8_SCHED;
            PG8_STAGE(PG8_SB(0, 1), b2 + hstepB, voffB);
            PG8_WAIT_V(6); PG8_BAR; PG8_MMA(1, 1, At, B1); PG8_BAR;
            PG8_LDB(B0, 1, 0); PG8_SCHED; PG8_LDA(At, 1, 0); PG8_STAGE(PG8_SA(0, 1), a2 + hstepA, voffA);
            PG8_WAIT_L(8); PG8_BAR; PG8_WAIT_L(0); PG8_MMA(0, 0, At, B0); PG8_BAR; PG8_SCHED;
            PG8_LDB(B1, 1, 1); PG8_STAGE(PG8_SB(1, 0), b3, voffB);
            PG8_BAR; PG8_WAIT_L(0); PG8_MMA(0, 1, At, B1); PG8_BAR;
            PG8_LDA(At, 1, 1); PG8_STAGE(PG8_SA(1, 0), a3, voffA);
            PG8_BAR; PG8_WAIT_L(0); PG8_MMA(1, 0, At, B0); PG8_BAR; PG8_SCHED;
            PG8_STAGE(PG8_SB(1, 1), b3 + hstepB, voffB);
            PG8_WAIT_V(6); PG8_BAR; PG8_MMA(1, 1, At, B1); PG8_BAR;
            }
        }
        if constexpr (ALIGN_EPI) { if (wr == 0) PG8_BAR; }
        if constexpr (!Epi::AFTER_DRAIN) { E(acc, cur, wr, wc, fr, fq); S.done(cur); }
        if (!has_next) break;
#pragma unroll
        for (int a = 0; a < 2; ++a)
#pragma unroll
            for (int b = 0; b < 2; ++b)
#pragma unroll
                for (int m = 0; m < 4; ++m)
#pragma unroll
                    for (int n = 0; n < 2; ++n) acc[a][b][m][n] = (f32x4){0.f, 0.f, 0.f, 0.f};
        cur = nxt; cA = nA; cB = nB; ++ui;
        if constexpr (ALIGN_EPI) { if (wr == 1) PG8_BAR; }
    }
    PG8_WAIT_V(0);
    if constexpr (!ALIGN_EPI) { if (wr == 0) PG8_BAR; }
    PG8_BAR;
    if constexpr (Epi::AFTER_DRAIN) { E.fused(acc, cur, wr, wc, fr, fq, lds, wid, lane); S.done(cur); }
#undef PG8_SA
#undef PG8_SB
#undef PG8_STAGE
#undef PG8_LDA
#undef PG8_LDB
#undef PG8_MMA
#undef PG8_WAIT_V
#undef PG8_WAIT_L
#undef PG8_BAR
#undef PG8_SCHED
}
}
#define LAS __attribute__((address_space(3)))
typedef unsigned short bf16_t;
typedef short bf16x8 __attribute__((ext_vector_type(8)));
typedef short s16x4 __attribute__((ext_vector_type(4)));
typedef float f32x4 __attribute__((ext_vector_type(4)));
typedef float f32x16 __attribute__((ext_vector_type(16)));
typedef unsigned u32x4 __attribute__((ext_vector_type(4)));
using pg8::u32x2; using pg8::pk_bf16; using pg8::bf_lo; using pg8::bf_hi; using pg8::bf2f;
constexpr int T = 2048, NB = 4, M = NB * T, D = 2048, DFF = 5632, HYBN = 5888, MLAN = 1280;
constexpr size_t MiB = 1u << 20;
constexpr size_t WS_CTL = 0, WS_SSQ = 1 * MiB, WS_SSQ2 = 2 * MiB, WS_CUM = 3 * MiB, WS_SEL = 3 * MiB + 256 * 1024, WS_BPART = 3 * MiB + 512 * 1024, WS_BIASPE = 3 * MiB + 768 * 1024,
                 WS_ROPE128 = 4 * MiB, WS_ROPE64 = 5 * MiB, WS_HID = 6 * MiB, WS_KCVC = 7 * MiB;
constexpr size_t WS_W1T = 8 * MiB, WS_W2T = 184 * MiB, WS_HYBIN = 272 * MiB, WS_HYBOUT = 295 * MiB, WS_MLAIN = 303 * MiB, WS_UQKV = 308 * MiB, WS_MLAOUT = 315 * MiB, WS_CMPW1 = 323 * MiB;
constexpr size_t WS_XB = 327 * MiB, WS_ACT = 359 * MiB, WS_OBUF = 447 * MiB, WS_MIX = 479 * MiB;
constexpr size_t WS_PBUF = WS_MIX, WS_QR = WS_MIX + 92 * MiB, WS_CMPIN = WS_MIX + 108 * MiB, WS_OWIN = WS_MIX + 117 * MiB, WS_OCMP = WS_MIX + 133 * MiB;
constexpr size_t WS_C = WS_MIX, WS_QBUF = WS_MIX + 20 * MiB, WS_KVBUF = WS_MIX + 68 * MiB;
constexpr size_t WS_END = WS_MIX + 149 * MiB;
constexpr int LDS_BYTES = 147456, MISC_OFF = 131072;
constexpr float LOG2E = 1.4426950408889634f;

struct Args { const float* in[21]; float* out; unsigned char* ws; };

__device__ __forceinline__ float wave_sum(float v) {
#pragma unroll
    for (int o = 1; o < 64; o <<= 1) v += __shfl_xor(v, o);
    return v;
}
template <int MODE> __device__ __forceinline__ int mapcol(int n, int N) {
    if (MODE == 0) return n < N ? n : -1;
    if (MODE == 1) { const int t = n >> 8, r = n & 255; return r < 128 ? 128 * t + r : DFF + 128 * t + (r - 128); }
    if (MODE == 2) { if (n < 2560) return n; if (n < 5632) return n + 24; if (n < 5656) return 2560 + (n - 5632); if (n < 5664) return n; return -1; }
    if (MODE == 3) { const int h = n / 192, c = n % 192; if (c < 128) return n; const int p = c - 128; return h * 192 + 128 + (p >> 1) + 32 * (p & 1); }
    if (MODE == 4) { if (n < 1024) return n; if (n < 1088) { const int p = n - 1024; return 1024 + (p >> 1) + 32 * (p & 1); } return -1; }
    return -1;
}
template <int MODE> __device__ __forceinline__ void transpose_item(const float* W, int K, int N, int NP, const float* gain, bf16_t* WT, LAS float* scr, int item, int lane) {
    const int nblk = NP / 32, kb = item / nblk, nb = item % nblk, k0 = 64 * kb, n0 = 32 * nb;
    const int sc = mapcol<MODE>(n0 + (lane & 31), N);
    float v[32];
#pragma unroll
    for (int i = 0; i < 32; ++i) { const int kk = 2 * i + (lane >> 5); v[i] = (sc >= 0) ? W[(size_t)(k0 + kk) * N + sc] : 0.f; }
    if (gain) {
#pragma unroll
        for (int i = 0; i < 32; ++i) v[i] *= gain[k0 + 2 * i + (lane >> 5)]; }
#pragma unroll
    for (int i = 0; i < 32; ++i) scr[(2 * i + (lane >> 5)) * 33 + (lane & 31)] = v[i];
    asm volatile("s_waitcnt lgkmcnt(0)" ::: "memory");
    const int c = lane & 7;
#pragma unroll
    for (int j = 0; j < 4; ++j) { const int n = (lane >> 3) + 8 * j; const LAS float* s = scr + (8 * c) * 33 + n;
        u32x4 o; o.x = pk_bf16(s[0 * 33], s[1 * 33]); o.y = pk_bf16(s[2 * 33], s[3 * 33]); o.z = pk_bf16(s[4 * 33], s[5 * 33]); o.w = pk_bf16(s[6 * 33], s[7 * 33]);
        *(u32x4*)(WT + (size_t)(n0 + n) * K + k0 + 8 * c) = o; }
    asm volatile("s_waitcnt lgkmcnt(0)" ::: "memory");
}
#define XB_TMO      128
#define XB_XCNT(j)  (256  + 64 * (j))
#define XB_XSUB(j)  (1280 + 64 * (j))
#define XB_XGEN(j)  (2304 + 64 * (j))
#define XB_TOP      3328
#define XB_TOPGEN   3392
#define XCD_BAR_WORDS 3456
#define XB_SPIN_CAP (1u << 18)

__device__ __forceinline__ unsigned xb_ld(unsigned* p)              { return __hip_atomic_load(p, __ATOMIC_RELAXED, __HIP_MEMORY_SCOPE_AGENT); }
__device__ __forceinline__ unsigned xb_add(unsigned* p, unsigned v) { return __hip_atomic_fetch_add(p, v, __ATOMIC_RELAXED, __HIP_MEMORY_SCOPE_AGENT); }
__device__ __forceinline__ unsigned xb_xcc_id() { return (unsigned)__builtin_amdgcn_s_getreg((3 << 11) | 20) & 0xFu; }
#define XB_SPIN(cond, bar) do { unsigned _sp = 0; while (cond) { __builtin_amdgcn_s_sleep(1); \
    if ((++_sp & 255u) == 0u) { if (xb_ld(&(bar)[XB_TMO])) break; if (_sp > XB_SPIN_CAP) { atomicAdd(&(bar)[XB_TMO], 1u); break; } } } } while (0)

struct XcdBarrier {
    unsigned* bar; unsigned x;
    volatile LAS unsigned* st;
};

__device__ __forceinline__ XcdBarrier xcd_barrier_post(unsigned* bar, volatile LAS unsigned* st) {
    XcdBarrier b; b.bar = bar; b.x = xb_xcc_id(); b.st = st;
    if (threadIdx.x == 0) (void)xb_add(&bar[XB_XCNT(b.x)], 1u);
    return b;
}
__device__ __forceinline__ void xcd_barrier_complete(unsigned* bar, unsigned x, unsigned& nloc, unsigned& nx) {
    const unsigned G = gridDim.x * gridDim.y * gridDim.z;
    unsigned sum, cnt, mine, sp = 0u;
    for (;;) {
        sum = 0u; cnt = 0u; mine = 0u;
#pragma unroll
        for (unsigned j = 0; j < 16; ++j) { const unsigned c = xb_ld(&bar[XB_XCNT(j)]); sum += c; cnt += (c > 0u) ? 1u : 0u; mine = (j == x) ? c : mine; }
        if (sum == G) break;
        __builtin_amdgcn_s_sleep(1);
        if ((++sp & 255u) == 0u) { if (xb_ld(&bar[XB_TMO])) break; if (sp > XB_SPIN_CAP) { atomicAdd(&bar[XB_TMO], 1u); break; } }
    }
    nloc = mine > 0u ? mine : 1u; nx = cnt > 0u ? cnt : 1u;
}

__device__ __forceinline__ void xcd_barrier(const XcdBarrier& b) {
    asm volatile("s_waitcnt vmcnt(0)" ::: "memory");
    __syncthreads();
    if (threadIdx.x == 0) {
        unsigned* bar = b.bar; unsigned xx = __builtin_amdgcn_readfirstlane(b.x); asm volatile("" : "+s"(xx));
        __builtin_amdgcn_s_waitcnt(0);
        unsigned nloc = b.st[0], nx = b.st[1];
        if (nloc == 0u) { xcd_barrier_complete(bar, xx, nloc, nx); b.st[0] = nloc; b.st[1] = nx; }
        const unsigned old = xb_add(&bar[XB_XSUB(xx)], 1u);
        const unsigned gen = old / nloc;
        if (old + 1u == (gen + 1u) * nloc) {
            __builtin_amdgcn_fence(__ATOMIC_RELEASE, "agent");
            asm volatile("s_waitcnt vmcnt(0)" ::: "memory");
            const unsigned og = xb_add(&bar[XB_TOP], 1u);
            const unsigned tg = og / nx;
            if (og + 1u == (tg + 1u) * nx) xb_add(&bar[XB_TOPGEN], 1u);
            else XB_SPIN(xb_ld(&bar[XB_TOPGEN]) == tg, bar);
            __builtin_amdgcn_fence(__ATOMIC_ACQUIRE, "agent");
            xb_add(&bar[XB_XGEN(xx)], 1u);
            asm volatile("s_waitcnt vmcnt(0)" ::: "memory");
        } else {
            XB_SPIN(xb_ld(&bar[XB_XGEN(xx)]) == gen, bar);
            __builtin_amdgcn_fence(__ATOMIC_ACQUIRE, "agent");
            asm volatile("s_waitcnt vmcnt(0)" ::: "memory");
        }
    }
    __syncthreads();
}

#define MFMA32(a, b, c) __builtin_amdgcn_mfma_f32_32x32x16_bf16((a), (b), (c), 0, 0, 0)
__device__ __forceinline__ s16x4 tr_read(LAS unsigned char* p) { return __builtin_amdgcn_ds_read_tr16_b64_v4i16((LAS s16x4*)p); }
__device__ __forceinline__ float fast_exp2(float x) { return __builtin_amdgcn_exp2f(x); }
__device__ __forceinline__ float sigmoid_f(float x) { return __builtin_amdgcn_rcpf(1.f + __expf(-x)); }
constexpr int KP128 = 272, KP192 = 400, VP = 320;
struct AttnArgs {
    const bf16_t* Q; int ldq, qhs;
    const bf16_t* K; int ldk, khs;
    const bf16_t* K2; int ldk2;
    const bf16_t* V; int ldv, vhs;
    bf16_t* O; int ldo, ocol0;
    float sc2;
    const float* cum2_;
    const unsigned* sel_;
    const bf16_t* P;
    const bf16_t* ocmp_; const bf16_t* owin_;
};
template <int MODE, int DK, int HG>
__device__ __forceinline__ void attn_unit(LAS unsigned char* lds, const AttnArgs& A, int b, int kvh, int qb) {
    constexpr int KPB = (DK == 128) ? KP128 : KP192, NKK = DK / 16, QT = 256 / HG;
    constexpr int KS_OFF = 0, VS_OFF = 64 * KPB, CK_OFF = VS_OFF + 64 * VP, STG = CK_OFF + 256, UM_OFF = 2 * STG;
    int tid_op = threadIdx.x; asm volatile("" : "+v"(tid_op));
    const int tid = tid_op, w = __builtin_amdgcn_readfirstlane(tid >> 6), lane = tid & 63, r = lane & 31, hh = lane >> 5;
    const int hd = (HG == 4) ? kvh * 4 + (w & 3) : kvh;
    const int t0 = qb * QT, tw0 = t0 + 32 * (w / HG), t = tw0 + r; const size_t mrow = (size_t)b * T + t; const size_t brow = (size_t)b * T;
    LAS unsigned* ums = (LAS unsigned*)(lds + UM_OFF);
    bf16x8 qf[NKK];
    { const bf16_t* qp = A.Q + mrow * A.ldq + (size_t)hd * A.qhs + 8 * hh;
#pragma unroll
      for (int kk = 0; kk < NKK; ++kk) qf[kk] = *(const bf16x8*)(qp + 16 * kk); }
    float cq = 0.f; unsigned selw = 0xffffffffu; unsigned um = 0xffffffffu;
    if (MODE == 1) cq = A.cum2_[mrow * 8 + hd];
    if (MODE == 3) {
        selw = A.sel_[mrow * 2 + kvh];
        __syncthreads();
        if (w == 0) { unsigned v = A.sel_[(brow + t0 + lane) * 2 + kvh];
#pragma unroll
            for (int o = 1; o < 64; o <<= 1) v |= __shfl_xor(v, o);
            if (lane == 0) ums[0] = v; }
        __syncthreads(); um = ums[0];
    }
    int j0, j1;
    if (MODE == 2) { j0 = t0 / 64 - 8; if (j0 < 0) j0 = 0; j1 = t0 / 64 + 1; } else { j0 = 0; j1 = (t0 + QT) / 64; }
    f32x16 Oa[4];
#pragma unroll
    for (int i = 0; i < 4; ++i)
#pragma unroll
        for (int e = 0; e < 16; ++e) Oa[i][e] = 0.f;
    float mrun = -1e30f, lrun = 0.f;
    u32x4 kreg[3], vreg[2]; float ckreg = 0.f;
#define AT_LOADK(jj) do { const size_t kvrow = brow + (size_t)(jj) * 64; \
        _Pragma("unroll") for (int i = 0; i < 2; ++i) { const int c = tid + 512 * i, row = c >> 4, cc = c & 15; \
            kreg[i] = *(const u32x4*)(A.K + (kvrow + row) * A.ldk + (size_t)kvh * A.khs + 8 * cc); } \
        if (DK == 192) { const int row = tid >> 3, cc = tid & 7; kreg[2] = *(const u32x4*)(A.K2 + (kvrow + row) * A.ldk2 + 8 * cc); } } while (0)
#define AT_LOADV(jj) do { const size_t kvrow = brow + (size_t)(jj) * 64; \
        _Pragma("unroll") for (int i = 0; i < 2; ++i) { const int c = tid + 512 * i, row = c >> 4, cc = c & 15; \
            vreg[i] = *(const u32x4*)(A.V + (kvrow + row) * A.ldv + (size_t)kvh * A.vhs + 8 * cc); } \
        if (MODE == 1) { if (tid < 64) ckreg = A.cum2_[(kvrow + tid) * 8 + hd]; } } while (0)
#define AT_STOREK(sb) do { LAS unsigned char* Ks_ = lds + (sb) * STG + KS_OFF; \
        _Pragma("unroll") for (int i = 0; i < 2; ++i) { const int c = tid + 512 * i, row = c >> 4, cc = c & 15; *(LAS u32x4*)(Ks_ + row * KPB + 16 * cc) = kreg[i]; } \
        if (DK == 192) { const int row = tid >> 3, cc = tid & 7; *(LAS u32x4*)(Ks_ + row * KPB + 256 + 16 * cc) = kreg[2]; } } while (0)
#define AT_STOREV(sb) do { LAS unsigned char* Vs_ = lds + (sb) * STG + VS_OFF; LAS float* cks_ = (LAS float*)(lds + (sb) * STG + CK_OFF); \
        _Pragma("unroll") for (int i = 0; i < 2; ++i) { const int c = tid + 512 * i, row = c >> 4, cc = c & 15; *(LAS u32x4*)(Vs_ + row * VP + 16 * cc) = vreg[i]; } \
        if (MODE == 1) { if (tid < 64) cks_[tid] = ckreg; } } while (0)
#define AT_NEXT(jj, res) do { int q_ = (jj) + 1; if (MODE == 3) { while (q_ < j1 && !((um >> q_) & 1u)) ++q_; } res = q_; } while (0)
#define AT_ACTIVE(jj) (((jj) * 64 <= tw0 + 31) && (MODE != 2 || (jj) * 64 + 63 > tw0 - 512))
    constexpr int FB = (DK == 192) ? 3 : 4, NFB = 2 * NKK / FB;
#define AT_LDF(dst, bi) do { _Pragma("unroll") for (int q_ = 0; q_ < FB; ++q_) { const int f_ = FB * (bi) + q_, kb_ = f_ / NKK, kk_ = f_ % NKK; \
            dst[q_] = *(const LAS bf16x8*)(Ks_ + (32 * kb_ + r) * KPB + (16 * kk_ + 8 * hh) * 2); } } while (0)
#define AT_MMF(src, bi) do { _Pragma("unroll") for (int q_ = 0; q_ < FB; ++q_) { const int f_ = FB * (bi) + q_, kb_ = f_ / NKK, kk_ = f_ % NKK; \
            if (kk_ == 0) S[kb_] = MFMA32(src[q_], qf[kk_], fz_); else S[kb_] = MFMA32(src[q_], qf[kk_], S[kb_]); } } while (0)
#define AT_QK(jj, sb) do { if (AT_ACTIVE(jj)) { LAS unsigned char* Ks_ = lds + (sb) * STG + KS_OFF; \
        f32x16 fz_; _Pragma("unroll") for (int e = 0; e < 16; ++e) fz_[e] = 0.f;     \
        bf16x8 fa_[FB], fb_[FB]; \
        AT_LDF(fa_, 0); __builtin_amdgcn_sched_barrier(0); \
        _Pragma("unroll") for (int bi = 0; bi < NFB; ++bi) { \
            if (bi & 1) { if (bi + 1 < NFB) AT_LDF(fa_, bi + 1); __builtin_amdgcn_sched_barrier(0); AT_MMF(fb_, bi); __builtin_amdgcn_sched_barrier(0); } \
            else        { if (bi + 1 < NFB) AT_LDF(fb_, bi + 1); __builtin_amdgcn_sched_barrier(0); AT_MMF(fa_, bi); __builtin_amdgcn_sched_barrier(0); } } } } while (0)
    const int trq = (lane & 15) >> 2, trp = lane & 3, trb = (lane >> 4) & 1;
    const bool grpB = w >= 4;
    f32x16 S[2]; bf16x8 pf[2][2];
    int jc = j0, jn1, jn2;
    AT_NEXT(jc, jn1); if (jn1 < j1) { AT_NEXT(jn1, jn2); } else jn2 = j1;
    __syncthreads();
    AT_LOADK(jc); AT_LOADV(jc); AT_STOREK(0); AT_STOREV(0);
    if (jn1 < j1) { AT_LOADK(jn1); AT_STOREK(1); }
    if (jn2 < j1) AT_LOADK(jn2);
    if (jn1 < j1) AT_LOADV(jn1);
    __syncthreads();
    AT_QK(jc, 0);
    if (grpB) __syncthreads();
    int n = 0;
    for (;;) {
        const int kv0 = jc * 64;
        const bool active = AT_ACTIVE(jc);
        bool anychg = false; float alpha = 1.f;
        if (active) {
            LAS float* cks = (LAS float*)(lds + (n & 1) * STG + CK_OFF); (void)cks;
            const bool need_mask = (kv0 + 63 > tw0) || (MODE == 2 && kv0 <= tw0 + 31 - 512);
            const bool selok = (MODE != 3) || ((selw >> jc) & 1u);
            float mloc = -1e30f; float muse; float psum = 0.f;
            if (MODE == 1) {
            if (need_mask) {
#pragma unroll
            for (int kb = 0; kb < 2; ++kb)
#pragma unroll
                for (int g4 = 0; g4 < 4; ++g4) {
                    const f32x4 ck4 = *(const LAS f32x4*)(cks + 32 * kb + 8 * g4 + 4 * hh);
#pragma unroll
                    for (int e = 0; e < 4; ++e) { const int key = kv0 + 32 * kb + 8 * g4 + 4 * hh + e;
                        float s2 = S[kb][4 * g4 + e] * A.sc2 + (cq - ck4[e]);
                        s2 = (key <= t) ? s2 : -1e30f; S[kb][4 * g4 + e] = s2; mloc = fmaxf(mloc, s2); }
                }
            } else {
#pragma unroll
            for (int kb = 0; kb < 2; ++kb)
#pragma unroll
                for (int g4 = 0; g4 < 4; ++g4) {
                    const f32x4 ck4 = *(const LAS f32x4*)(cks + 32 * kb + 8 * g4 + 4 * hh);
#pragma unroll
                    for (int e = 0; e < 4; ++e) { const float s2 = S[kb][4 * g4 + e] * A.sc2 + (cq - ck4[e]); S[kb][4 * g4 + e] = s2; mloc = fmaxf(mloc, s2); }
                }
            }
            mloc = fmaxf(mloc, __shfl_xor(mloc, 32));
            const float mnew = fmaxf(mrun, mloc); muse = (mnew < -1e29f) ? 0.f : mnew;
            alpha = fast_exp2(mrun - muse); anychg = __builtin_amdgcn_ballot_w64(mnew > mrun) != 0ull; mrun = mnew;
#pragma unroll
            for (int kb = 0; kb < 2; ++kb)
#pragma unroll
                for (int e = 0; e < 16; ++e) { const float p = fast_exp2(S[kb][e] - muse); S[kb][e] = p; psum += p; }
            } else {
            if (need_mask) {
#pragma unroll
            for (int kb = 0; kb < 2; ++kb)
#pragma unroll
                for (int e = 0; e < 16; ++e) { const int key = kv0 + 32 * kb + (e & 3) + 8 * (e >> 2) + 4 * hh;
                    bool valid = selok && (key <= t); if (MODE == 2) valid = valid && (key > t - 512);
                    const float sr = valid ? S[kb][e] : -3e38f; S[kb][e] = sr; mloc = fmaxf(mloc, sr); }
            } else {
#pragma unroll
            for (int kb = 0; kb < 2; ++kb)
#pragma unroll
                for (int e = 0; e < 16; ++e) { float sr = S[kb][e]; if (MODE == 3) { sr = selok ? sr : -3e38f; S[kb][e] = sr; } mloc = fmaxf(mloc, sr); }
            }
            mloc = fmaxf(mloc, __shfl_xor(mloc, 32)) * A.sc2;
            const float mnew = fmaxf(mrun, mloc); muse = (mnew < -1e29f) ? 0.f : mnew;
            alpha = fast_exp2(mrun - muse); anychg = __builtin_amdgcn_ballot_w64(mnew > mrun) != 0ull; mrun = mnew;
            const float negm = -muse, scv = A.sc2;
#pragma unroll
            for (int kb = 0; kb < 2; ++kb)
#pragma unroll
                for (int e = 0; e < 16; ++e) { float y; asm("v_fma_f32 %0, %1, %2, %3" : "=v"(y) : "v"(S[kb][e]), "s"(scv), "v"(negm)); const float p = fast_exp2(y); S[kb][e] = p; psum += p; }
            }
            lrun = lrun * alpha + psum;
#pragma unroll
            for (int kb = 0; kb < 2; ++kb)
#pragma unroll
                for (int s = 0; s < 2; ++s) { u32x4 pw; pw.x = pk_bf16(S[kb][8 * s], S[kb][8 * s + 1]); pw.y = pk_bf16(S[kb][8 * s + 2], S[kb][8 * s + 3]); pw.z = pk_bf16(S[kb][8 * s + 4], S[kb][8 * s + 5]); pw.w = pk_bf16(S[kb][8 * s + 6], S[kb][8 * s + 7]);
                    pf[kb][s] = __builtin_bit_cast(bf16x8, pw); }
            if (anychg) {
#pragma unroll
            for (int i = 0; i < 4; ++i)
#pragma unroll
                for (int e = 0; e < 16; ++e) Oa[i][e] *= alpha;
            }
        }
        __syncthreads();
        const bool has1 = jn1 < j1;
        if (jn2 < j1) AT_STOREK(n & 1);
        if (has1) AT_STOREV((n + 1) & 1);
        int jn3 = j1; if (jn2 < j1) { AT_NEXT(jn2, jn3); }
        if (jn3 < j1) AT_LOADK(jn3);
        if (jn2 < j1) AT_LOADV(jn2);
        __builtin_amdgcn_s_setprio(1);
        if (active) {
            LAS unsigned char* Vs = lds + (n & 1) * STG + VS_OFF;
            LAS unsigned char* vbase = Vs + (4 * hh + trq) * VP + (16 * trb + 4 * trp) * 2;
            bf16x8 va[4], vb[4];
#define AT_LDV(dst, dvb_) do { _Pragma("unroll") for (int q_ = 0; q_ < 4; ++q_) { LAS unsigned char* vp_ = vbase + (32 * (q_ >> 1) + 16 * (q_ & 1)) * VP + (32 * (dvb_)) * 2; \
                const s16x4 lo_ = tr_read(vp_), hi_ = tr_read(vp_ + 8 * VP); dst[q_] = __builtin_shufflevector(lo_, hi_, 0, 1, 2, 3, 4, 5, 6, 7); } } while (0)
#define AT_MMV(src, dvb_) do { _Pragma("unroll") for (int q_ = 0; q_ < 4; ++q_) Oa[dvb_] = MFMA32(src[q_], pf[q_ >> 1][q_ & 1], Oa[dvb_]); } while (0)
#define SB_ __builtin_amdgcn_sched_barrier(0)
            SB_; AT_LDV(va, 0); SB_; AT_LDV(vb, 1); SB_; AT_MMV(va, 0); SB_; AT_LDV(va, 2); SB_; AT_MMV(vb, 1); SB_; AT_LDV(vb, 3); SB_; AT_MMV(va, 2); SB_; AT_MMV(vb, 3); SB_;
#undef SB_
#undef AT_LDV
#undef AT_MMV
        }
        if (has1) AT_QK(jn1, (n + 1) & 1);
        __builtin_amdgcn_s_setprio(0);
        __syncthreads();
        if (!has1) break;
        jc = jn1; jn1 = jn2; jn2 = jn3; ++n;
    }
    if (!grpB) __syncthreads();
    const float ltot = lrun + __shfl_xor(lrun, 32);
    float inv = ltot > 0.f ? 1.f / ltot : 0.f;
    if (MODE == 2) inv *= sigmoid_f(bf2f(A.P[mrow * HYBN + 5632 + hd * 3 + 2]));
    if (MODE == 3) inv *= sigmoid_f(bf2f(A.P[mrow * HYBN + 5632 + hd * 3 + 1]));
    bf16_t* op = A.O + mrow * A.ldo + A.ocol0 + hd * 128 + 4 * hh;
#pragma unroll
    for (int dvb = 0; dvb < 4; ++dvb)
#pragma unroll
        for (int g4 = 0; g4 < 4; ++g4) {
            float v0 = Oa[dvb][4 * g4] * inv, v1 = Oa[dvb][4 * g4 + 1] * inv, v2 = Oa[dvb][4 * g4 + 2] * inv, v3 = Oa[dvb][4 * g4 + 3] * inv;
            if (MODE == 3) { const size_t o = mrow * 1024 + hd * 128 + 32 * dvb + 8 * g4 + 4 * hh; const u32x2 a = *(const u32x2*)(A.ocmp_ + o), c = *(const u32x2*)(A.owin_ + o);
                v0 += bf_lo(a.x) + bf_lo(c.x); v1 += bf_hi(a.x) + bf_hi(c.x); v2 += bf_lo(a.y) + bf_lo(c.y); v3 += bf_hi(a.y) + bf_hi(c.y); }
            u32x2 o2; o2.x = pk_bf16(v0, v1); o2.y = pk_bf16(v2, v3); *(u32x2*)(op + 32 * dvb + 8 * g4) = o2; }
}
#undef AT_LOADK
#undef AT_LOADV
#undef AT_STOREK
#undef AT_STOREV
#undef AT_NEXT
#undef AT_ACTIVE
#undef AT_QK
#undef AT_LDF
#undef AT_MMF
__device__ __forceinline__ void cmp_unit(LAS unsigned char* lds, const bf16_t* P, const bf16_t* KC, const bf16_t* VC, bf16_t* OCMP, unsigned* SEL, int b, int g, int qb) {
    constexpr int VS_OFF = 128 * KP128, IMP_OFF = VS_OFF + 128 * VP;
    int tid_op = threadIdx.x; asm volatile("" : "+v"(tid_op));
    const int tid = tid_op, w = __builtin_amdgcn_readfirstlane(tid >> 6), lane = tid & 63, r = lane & 31, hh = lane >> 5;
    const int hd = g * 4 + (w & 3), t0 = qb * 64, t = t0 + 32 * (w >> 2) + r; const size_t mrow = (size_t)b * T + t;
    LAS unsigned char* Ks = lds; LAS unsigned char* Vs = lds + VS_OFF; LAS float* IMPW = (LAS float*)(lds + IMP_OFF);
    __syncthreads();
    { const bf16_t* kc = KC + (size_t)(b * 2 + g) * 128 * 128; const bf16_t* vc = VC + (size_t)(b * 2 + g) * 128 * 128;
#pragma unroll
      for (int i = 0; i < 4; ++i) { const int c = tid + 512 * i, row = c >> 4, cc = c & 15;
          *(LAS u32x4*)(Ks + row * KP128 + 16 * cc) = *(const u32x4*)(kc + row * 128 + 8 * cc);
          *(LAS u32x4*)(Vs + row * VP + 16 * cc) = *(const u32x4*)(vc + row * 128 + 8 * cc); } }
    bf16x8 qf[8];
    { const bf16_t* qp = P + mrow * HYBN + hd * 128 + 8 * hh;
#pragma unroll
      for (int kk = 0; kk < 8; ++kk) qf[kk] = *(const bf16x8*)(qp + 16 * kk); }
    __syncthreads();
    f32x16 S[4];
#pragma unroll
    for (int kb = 0; kb < 4; ++kb) {
#pragma unroll
        for (int e = 0; e < 16; ++e) S[kb][e] = 0.f;
#pragma unroll
        for (int kk = 0; kk < 8; ++kk) { const bf16x8 kf = *(const LAS bf16x8*)(Ks + (32 * kb + r) * KP128 + (16 * kk + 8 * hh) * 2); S[kb] = MFMA32(kf, qf[kk], S[kb]); }
    }
    const float sc2 = 0.08838834764831845f * LOG2E;
    float mloc = -1e30f;
#pragma unroll
    for (int kb = 0; kb < 4; ++kb)
#pragma unroll
        for (int e = 0; e < 16; ++e) { const int n = 32 * kb + (e & 3) + 8 * (e >> 2) + 4 * hh; const bool valid = (n < 127) && (16 * n + 31 <= t);
            const float s2 = valid ? S[kb][e] * sc2 : -1e30f; S[kb][e] = s2; mloc = fmaxf(mloc, s2); }
    mloc = fmaxf(mloc, __shfl_xor(mloc, 32));
    const float muse = (mloc < -1e29f) ? 0.f : mloc;
    float psum = 0.f;
#pragma unroll
    for (int kb = 0; kb < 4; ++kb)
#pragma unroll
        for (int e = 0; e < 16; ++e) { const float p = fast_exp2(S[kb][e] - muse); S[kb][e] = p; psum += p; }
    const float ltot = psum + __shfl_xor(psum, 32);
    const float inv = ltot > 0.f ? 1.f / ltot : 0.f;
    {
        float prevrecv = 0.f;
#pragma unroll
        for (int kb = 0; kb < 4; ++kb)
#pragma unroll
            for (int g4 = 0; g4 < 4; ++g4) { const int Gi = 4 * kb + g4;
                const float p0 = S[kb][4 * g4], p1 = S[kb][4 * g4 + 1], p2 = S[kb][4 * g4 + 2], p3 = S[kb][4 * g4 + 3];
                const float ai = ((p0 + p1) + p2 + 0.5f * p3) * inv, bi = 0.5f * p3 * inv;
                const float recv = __shfl_xor(bi, 32);
                const float tot = ai + (hh ? recv : prevrecv); prevrecv = recv;
                IMPW[(w * 32 + r) * 33 + 2 * Gi + hh] = tot; }
    }
    f32x16 Oa[4];
#pragma unroll
    for (int i = 0; i < 4; ++i)
#pragma unroll
        for (int e = 0; e < 16; ++e) Oa[i][e] = 0.f;
    const int trq = (lane & 15) >> 2, trp = lane & 3, trb = (lane >> 4) & 1;
#pragma unroll
    for (int kb = 0; kb < 4; ++kb)
#pragma unroll
        for (int s = 0; s < 2; ++s) { u32x4 pw; pw.x = pk_bf16(S[kb][8 * s], S[kb][8 * s + 1]); pw.y = pk_bf16(S[kb][8 * s + 2], S[kb][8 * s + 3]); pw.z = pk_bf16(S[kb][8 * s + 4], S[kb][8 * s + 5]); pw.w = pk_bf16(S[kb][8 * s + 6], S[kb][8 * s + 7]);
            const bf16x8 pf = __builtin_bit_cast(bf16x8, pw);
#pragma unroll
            for (int dvb = 0; dvb < 4; ++dvb) { LAS unsigned char* vp = Vs + (32 * kb + 16 * s + 4 * hh + trq) * VP + (32 * dvb + 16 * trb + 4 * trp) * 2;
                const s16x4 lo = tr_read(vp), hi = tr_read(vp + 8 * VP);
                const bf16x8 vf = __builtin_shufflevector(lo, hi, 0, 1, 2, 3, 4, 5, 6, 7);
                Oa[dvb] = MFMA32(vf, pf, Oa[dvb]); } }
    const float og = inv * sigmoid_f(bf2f(P[mrow * HYBN + 5632 + hd * 3 + 0]));
    bf16_t* op = OCMP + mrow * 1024 + hd * 128 + 4 * hh;
#pragma unroll
    for (int dvb = 0; dvb < 4; ++dvb)
#pragma unroll
        for (int g4 = 0; g4 < 4; ++g4) { u32x2 o2; o2.x = pk_bf16(Oa[dvb][4 * g4] * og, Oa[dvb][4 * g4 + 1] * og); o2.y = pk_bf16(Oa[dvb][4 * g4 + 2] * og, Oa[dvb][4 * g4 + 3] * og); *(u32x2*)(op + 32 * dvb + 8 * g4) = o2; }
    __syncthreads();
    {
        const int cur = qb, jj = lane & 31, hsel = lane >> 5;
#pragma unroll 1
        for (int it = 0; it < 4; ++it) {
            const int tq = 2 * (w * 4 + it) + hsel, sub = tq >> 5, rr = tq & 31;
            const LAS float* ip = IMPW + ((4 * sub) * 32 + rr) * 33 + jj;
            const float imp = ((ip[0] + ip[32 * 33]) + ip[2 * 32 * 33]) + ip[3 * 32 * 33];
            const bool cand = (jj >= 1) && (jj <= cur - 2);
            const float val = cand ? imp : -1.f;
            int rank = 0;
#pragma unroll
            for (int k = 1; k < 30; ++k) { const float vk = __shfl(val, (lane & 32) | k); rank += ((vk > val) || (vk == val && k < jj)) ? 1 : 0; }
            const bool selb = cand && (rank < 5);
            const unsigned long long bal = __builtin_amdgcn_ballot_w64(selb);
            unsigned mask = (unsigned)(bal >> (32 * hsel));
            if (cur <= 7) mask = (2u << cur) - 1u; else mask |= 1u | (1u << cur) | (1u << (cur - 1));
            if (jj == 0) SEL[((size_t)b * T + t0 + tq) * 2 + g] = mask;
        }
    }
}
__device__ __forceinline__ int fetch_unit_x(unsigned* ctr8, int xcd, int per, LAS int* slot) {
    __syncthreads();
    if (threadIdx.x == 0) { int res = -1;
        for (int k = 0; k < 8; ++k) { const int x = (xcd + k) & 7; if (__hip_atomic_load(ctr8 + 64 * x, __ATOMIC_RELAXED, __HIP_MEMORY_SCOPE_AGENT) >= (unsigned)per) continue;
            const unsigned v = atomicAdd(ctr8 + 64 * x, 1u); if (v < (unsigned)per) { res = x * per + (int)v; break; } }
        *slot = res; }
    __syncthreads();
    return *slot;
}
__global__ void __launch_bounds__(512, 2) mega_fwd(Args a) {
    extern __shared__ __attribute__((aligned(16))) unsigned char lds_raw[];
    LAS unsigned char* lds = (LAS unsigned char*)lds_raw;
    LAS int* slot = (LAS int*)(lds + MISC_OFF);
    cg::grid_group grid = cg::this_grid();
    const int tid = threadIdx.x, lane = tid & 63, wave = tid >> 6, G = gridDim.x, bid = blockIdx.x;
    const int gw = bid * 8 + wave, NGW = G * 8, gtid = bid * 512 + tid, NGT = G * 512;
    unsigned char* ws = a.ws;
    unsigned* ctl = (unsigned*)(ws + WS_CTL);
#define SSQ ((float*)(a.ws + WS_SSQ))
#define SSQ2 ((float*)(a.ws + WS_SSQ2))
#define CUM2 ((float*)(a.ws + WS_CUM))
#define SEL ((unsigned*)(a.ws + WS_SEL))
#define BPART ((float*)(a.ws + WS_BPART))
#define BIASPE ((float*)(a.ws + WS_BIASPE))
#define ROPE128 ((float*)(a.ws + WS_ROPE128))
#define ROPE64 ((float*)(a.ws + WS_ROPE64))
#define HID ((bf16_t*)(a.ws + WS_HID))
#define KCVC ((bf16_t*)(a.ws + WS_KCVC))
#define HYBIN ((bf16_t*)(a.ws + WS_HYBIN))
#define HYBOUT ((bf16_t*)(a.ws + WS_HYBOUT))
#define MLAIN ((bf16_t*)(a.ws + WS_MLAIN))
#define UQKV ((bf16_t*)(a.ws + WS_UQKV))
#define MLAOUT ((bf16_t*)(a.ws + WS_MLAOUT))
#define CMPW1 ((bf16_t*)(a.ws + WS_CMPW1))
#define XB ((bf16_t*)(a.ws + WS_XB))
#define ACT ((bf16_t*)(a.ws + WS_ACT))
#define OBUF ((bf16_t*)(a.ws + WS_OBUF))
#define PBUF ((bf16_t*)(a.ws + WS_PBUF))
#define QR ((bf16_t*)(a.ws + WS_QR))
#define CMPIN ((bf16_t*)(a.ws + WS_CMPIN))
#define OWIN ((bf16_t*)(a.ws + WS_OWIN))
#define OCMP ((bf16_t*)(a.ws + WS_OCMP))
#define CB ((bf16_t*)(a.ws + WS_C))
#define QBUF ((bf16_t*)(a.ws + WS_QBUF))
#define KVBUF ((bf16_t*)(a.ws + WS_KVBUF))
    float* X = a.out;

    if (PROBE_TSMASK) { if (blockIdx.x == 0 && threadIdx.x == 0) ((unsigned long long*)(a.ws + 65536))[23] = __builtin_amdgcn_s_memrealtime(); }
    if (tid < 2) ((volatile LAS unsigned*)(lds + MISC_OFF + 32))[tid] = 0u;
    if (a.ws == nullptr) grid.sync();
    __syncthreads();
    XcdBarrier xbar = xcd_barrier_post(ctl + 4096, (volatile LAS unsigned*)(lds + MISC_OFF + 32));
    int ts_idx = 0; (void)ts_idx;
    if (PROBE_TSMASK) { if (bid == 0 && tid == 0) ((unsigned long long*)(a.ws + 65536))[0] = __builtin_amdgcn_s_memrealtime(); }
#pragma unroll 1
    for (int rep = 0; rep < 1 + PROBE_P0X2; ++rep) {
    {
        LAS float* scr = (LAS float*)(lds + wave * 16384);
#define TJOBX(MODE, W, K, N, NP, gain, dst, gw_, ngw_) for (int it = (gw_); it < ((K) / 64) * ((NP) / 32); it += (ngw_)) transpose_item<MODE>(W, K, N, NP, gain, dst, scr, it, lane)
#define TJOBQ(MODE, W, K, N, NP, gain, dst, ctr, it0, it1) do { int tid_q = threadIdx.x; asm volatile("" : "+v"(tid_q)); const int lane = tid_q & 63, wave = __builtin_amdgcn_readfirstlane(tid_q >> 6); \
        LAS float* scr = (LAS float*)(lds + wave * 16384); \
        for (;;) { __syncthreads(); if (tid_q == 0) *slot = (it0) + (int)atomicAdd((ctr), 8u); __syncthreads(); const int base_ = *slot; if (base_ >= (it1)) break; \
            if (base_ + wave < (it1)) transpose_item<MODE>(W, K, N, NP, gain, dst, scr, base_ + wave, lane); } } while (0)
#define TJOBR(MODE, W, K, N, NP, gain, dst, gw_, ngw_, it0, it1) for (int it = (it0) + (gw_); it < (it1); it += (ngw_)) transpose_item<MODE>(W, K, N, NP, gain, dst, scr, it, lane)
        TJOBX(1, a.in[2], 2048, 11264, 11264, a.in[1], (bf16_t*)(ws + WS_W1T), gw, NGW);
        TJOBX(0, a.in[3], 5632, 2048, 2048, (const float*)nullptr, (bf16_t*)(ws + WS_W2T), gw, NGW);
        TJOBR(1, a.in[6] + (size_t)2048 * 11264, 2048, 11264, 11264, a.in[5] + 2048, (bf16_t*)(ws + WS_W1T + (size_t)3 * 44 * MiB), gw, NGW, 9088, 11264);
    }
    for (int m = gw; m < M; m += NGW) {
        const f32x4* xr = (const f32x4*)(a.in[0] + (size_t)m * D) + lane; u32x2* xo = (u32x2*)(XB + (size_t)m * D) + lane; float s = 0.f;
#pragma unroll
        for (int j = 0; j < 8; ++j) { const f32x4 v = xr[64 * j]; s += (v[0] * v[0] + v[1] * v[1]) + (v[2] * v[2] + v[3] * v[3]); u32x2 o; o.x = pk_bf16(v[0], v[1]); o.y = pk_bf16(v[2], v[3]); xo[64 * j] = o; }
        s = wave_sum(s);
        if (lane < 32) SSQ[(size_t)m * 32 + lane] = lane == 0 ? s : 0.f;
    }
    for (int i = gtid; i < 2048 * 64; i += NGT) { const int t = i >> 6, ii = i & 63; const float e = (float)(2 * ii) / 128.f; const float pw = (float)pow(10000.0, (double)e); const float inv = 1.0f / pw; const float ang = (float)t * inv;
        ROPE128[2 * i] = cosf(ang); ROPE128[2 * i + 1] = sinf(ang); }
    for (int i = gtid; i < 2048 * 32; i += NGT) { const int t = i >> 5, ii = i & 31; const float e = (float)(2 * ii) / 64.f; const float pw = (float)pow(10000.0, (double)e); const float inv = 1.0f / pw; const float ang = (float)t * inv;
        ROPE64[2 * i] = cosf(ang); ROPE64[2 * i + 1] = sinf(ang); }
    if (bid < 64) { const int kv = tid >> 8, c = tid & 255; const float* pe = a.in[10] + kv * 4096 + bid * 64; const float* w1 = a.in[11] + (size_t)kv * 4096 * 256 + (size_t)bid * 64 * 256 + c; float s = 0.f;
#pragma unroll 8
        for (int k = 0; k < 64; ++k) s += pe[k] * w1[(size_t)k * 256];
        BPART[bid * 512 + tid] = s; }
    }
    GSYNC();

#pragma unroll 1
    for (int k = 0; k < 4; ++k) {
#pragma unroll 1
        for (int rep = 0; rep < 1 + PROBE_UPX2; ++rep) {
            pg8::Gemm g{XB, XB, (const bf16_t*)(ws + WS_W1T + (size_t)k * 44 * MiB), M, 11264, 2048, 2048, 1 << 30};
            pg8::StaticOrder S; S.init(M, 11264, G, bid);
            pg8::EpiSwiglu E{ACT, DFF, SSQ};
            pg8::gemm_phase<pg8::EpiSwiglu, pg8::StaticOrder, true, true>(lds, g, S, E);
        }
        if (bid >= G / 2) {
            int tid_o = threadIdx.x; asm volatile("" : "+v"(tid_o)); const int lane = tid_o & 63, wave = __builtin_amdgcn_readfirstlane(tid_o >> 6);
            LAS float* scr = (LAS float*)(lds + wave * 16384);
            const int tgw = (bid - G / 2) * 8 + wave, TNG = (G - G / 2) * 8;
            if (k == 0) {
                TJOBX(2, a.in[8], 2048, 5664, 5888, a.in[4], HYBIN, tgw, TNG);
                TJOBX(0, a.in[9], 2048, 2048, 2048, (const float*)nullptr, HYBOUT, tgw, TNG);
                TJOBX(0, a.in[11], 4096, 256, 256, (const float*)nullptr, CMPW1, tgw, TNG);
                TJOBX(0, a.in[11] + (size_t)4096 * 256, 4096, 256, 256, (const float*)nullptr, CMPW1 + (size_t)256 * 4096, tgw, TNG);
                TJOBR(1, a.in[6], 2048, 11264, 11264, a.in[5], (bf16_t*)(ws + WS_W1T + (size_t)1 * 44 * MiB), tgw, TNG, 0, 3680);
            } else if (k == 1) {
                TJOBX(0, a.in[7], 5632, 2048, 2048, (const float*)nullptr, (bf16_t*)(ws + WS_W2T + (size_t)1 * 22 * MiB), tgw, TNG);
                TJOBR(1, a.in[2] + (size_t)2048 * 11264, 2048, 11264, 11264, a.in[1] + 2048, (bf16_t*)(ws + WS_W1T + (size_t)2 * 44 * MiB), tgw, TNG, 0, 6656);
            } else if (k == 2) {
                TJOBX(0, a.in[3] + (size_t)5632 * 2048, 5632, 2048, 2048, (const float*)nullptr, (bf16_t*)(ws + WS_W2T + (size_t)2 * 22 * MiB), tgw, TNG);
                TJOBX(4, a.in[14], 2048, 1088, 1280, a.in[4] + 2048, MLAIN, tgw, TNG);
                TJOBX(3, a.in[17], 512, 3072, 3072, a.in[15], UQKV, tgw, TNG);
                TJOBX(0, a.in[18], 512, 4096, 4096, a.in[16], UQKV + (size_t)3072 * 512, tgw, TNG);
                TJOBX(0, a.in[19], 2048, 2048, 2048, (const float*)nullptr, MLAOUT, tgw, TNG);
                TJOBR(1, a.in[6] + (size_t)2048 * 11264, 2048, 11264, 11264, a.in[5] + 2048, (bf16_t*)(ws + WS_W1T + (size_t)3 * 44 * MiB), tgw, TNG, 0, 1728);
            } else {
                TJOBX(0, a.in[7] + (size_t)5632 * 2048, 5632, 2048, 2048, (const float*)nullptr, (bf16_t*)(ws + WS_W2T + (size_t)3 * 22 * MiB), tgw, TNG);
            }
        }
        GSYNC();
        {
            pg8::Gemm g{ACT, ACT, (const bf16_t*)(ws + WS_W2T + (size_t)k * 22 * MiB), M, 2048, DFF, DFF, 1 << 30};
            pg8::StaticOrder S; S.init(M, 2048, G, bid);
            pg8::EpiResid E{k == 0 ? a.in[0] : X, X, XB, SSQ, 0.5f};
            pg8::gemm_phase<pg8::EpiResid, pg8::StaticOrder, true, true>(lds, g, S, E);
        }
        GSYNC();
        if (k == 0) {
            {
                pg8::Gemm g{XB, XB, HYBIN, M, HYBN, 2048, 2048, 1 << 30};
                pg8::StaticOrder S; S.init(M, HYBN, G, bid);
                pg8::EpiScale<8, false> E{PBUF, HYBN, PBUF, HYBN, 1 << 30, SSQ, 0, 0, 1.f / 2048.f, nullptr, nullptr};
                pg8::gemm_phase<pg8::EpiScale<8, false>, pg8::StaticOrder, true, true>(lds, g, S, E);
            }
            if (bid >= 224 && G == 256) {
                int tid_o = threadIdx.x; asm volatile("" : "+v"(tid_o)); const int lane = tid_o & 63, wave = __builtin_amdgcn_readfirstlane(tid_o >> 6);
                LAS float* scr = (LAS float*)(lds + wave * 16384);
                TJOBR(1, a.in[6], 2048, 11264, 11264, a.in[5], (bf16_t*)(ws + WS_W1T + (size_t)1 * 44 * MiB), (bid - 224) * 8 + wave, 32 * 8, 3680, 6752);
            } else if (G != 256) {
                int tid_o = threadIdx.x; asm volatile("" : "+v"(tid_o)); const int lane = tid_o & 63, wave = __builtin_amdgcn_readfirstlane(tid_o >> 6);
                LAS float* scr = (LAS float*)(lds + wave * 16384);
                TJOBR(1, a.in[6], 2048, 11264, 11264, a.in[5], (bf16_t*)(ws + WS_W1T + (size_t)1 * 44 * MiB), bid * 8 + wave, G * 8, 3680, 6752);
            }
            GSYNC();
            {
                int tid_o = threadIdx.x; asm volatile("" : "+v"(tid_o)); const int tid = tid_o, lane = tid & 63, wave = __builtin_amdgcn_readfirstlane(tid >> 6), gw = bid * 8 + wave, gtid = bid * 512 + tid; (void)lane; (void)gw; (void)gtid;
                const bool ded = NGT > 4096; const int g2 = gtid - (ded ? 2048 : 0), N2 = NGT - (ded ? 2048 : 0);
                if (!ded || gw >= 32) {
                for (int i0 = g2; i0 < M * 12 * 8; i0 += 2 * N2) {
                    u32x4 x1[2], x2[2]; f32x4 cs[2][4]; bf16_t* dstp[2]; bool ok[2];
#pragma unroll
                    for (int e = 0; e < 2; ++e) {
                        const int i = i0 + e * N2; ok[e] = i < M * 12 * 8; const int ii = ok[e] ? i : i0;
                        const int c8 = ii & 7, u = (ii >> 3) % 12, m = ii / 96, t = m & (T - 1);
                        const bf16_t* src; bf16_t* dst;
                        if (u < 8) { src = PBUF + (size_t)m * HYBN + u * 128; dst = QR + (size_t)m * 1024 + u * 128; }
                        else if (u < 10) { src = PBUF + (size_t)m * HYBN + 1536 + (u - 8) * 128; dst = (bf16_t*)src; }
                        else { src = PBUF + (size_t)m * HYBN + 2048 + (u - 10) * 128; dst = (bf16_t*)src; }
                        x1[e] = *(const u32x4*)(src + 8 * c8); x2[e] = *(const u32x4*)(src + 64 + 8 * c8);
                        const f32x4* csp = (const f32x4*)(ROPE128 + ((size_t)t * 64 + 8 * c8) * 2);
#pragma unroll
                        for (int q = 0; q < 4; ++q) cs[e][q] = csp[q];
                        dstp[e] = dst + 8 * c8;
                    }
#pragma unroll
                    for (int e = 0; e < 2; ++e) { u32x4 o1, o2;
#pragma unroll
                        for (int q = 0; q < 4; ++q) { const f32x4 c = cs[e][q]; const float a0 = bf_lo(x1[e][q]), a1 = bf_hi(x1[e][q]), b0 = bf_lo(x2[e][q]), b1 = bf_hi(x2[e][q]);
                            o1[q] = pk_bf16(a0 * c[0] - b0 * c[1], a1 * c[2] - b1 * c[3]); o2[q] = pk_bf16(b0 * c[0] + a0 * c[1], b1 * c[2] + a1 * c[3]); }
                        if (ok[e]) { *(u32x4*)(dstp[e]) = o1; *(u32x4*)(dstp[e] + 64) = o2; } }
                }
                for (int i = g2; i < M * 4 * 16; i += N2) {
                    const int cc = i & 15, gg = (i >> 4) & 1, kv = (i >> 5) & 1, m = i >> 6, b = m >> 11, t = m & (T - 1);
                    *(u32x4*)(CMPIN + ((size_t)kv * 8 + b * 2 + gg) * T * 128 + (size_t)t * 128 + 8 * cc) = *(const u32x4*)(PBUF + (size_t)m * HYBN + 1024 + kv * 256 + gg * 128 + 8 * cc);
                }
                }
                if (gw < 32) {
                    const int b = gw >> 3, h = gw & 7; const float fb = a.in[13][h]; float v[32]; float s = 0.f;
#pragma unroll
                    for (int i = 0; i < 32; ++i) { const float z = bf2f(PBUF[((size_t)b * T + 32 * lane + i) * HYBN + 5656 + h]) + fb; const float lf = fminf(z, 0.f) - log1pf(__expf(-fabsf(z))); s += lf; v[i] = s; }
                    float incl = s;
#pragma unroll
                    for (int o = 1; o < 64; o <<= 1) { const float n = __shfl_up(incl, o); if (lane >= o) incl += n; }
                    const float excl = incl - s;
#pragma unroll
                    for (int i = 0; i < 32; ++i) CUM2[((size_t)b * T + 32 * lane + i) * 8 + h] = (excl + v[i]) * LOG2E;
                }
                if (gw >= 64 && gw < 64 + 512) { const int o = gw - 64; const float s = wave_sum(BPART[lane * 512 + o]); if (lane == 0) BIASPE[o] = s; }
            }
            GSYNC();
            {
                pg8::Gemm g{CMPIN, CMPIN + (size_t)8 * T * 128, CMPW1, 1024, 512, 4096, 2048, 1};
                pg8::ListOrder S; S.init(1024, 512, G, bid);
                pg8::EpiGelu E{HID, BIASPE};
                pg8::gemm_phase<pg8::EpiGelu, pg8::ListOrder, true, true>(lds, g, S, E);
                AttnArgs af{}; af.Q = PBUF + 2560; af.ldq = HYBN; af.qhs = 128; af.K = PBUF + 3584; af.ldk = HYBN; af.khs = 128; af.K2 = nullptr; af.ldk2 = 0; af.V = PBUF + 4608; af.ldv = HYBN; af.vhs = 128;
                af.O = OBUF; af.ldo = 2048; af.ocol0 = 1024; af.sc2 = 0.08838834764831845f * LOG2E; af.cum2_ = CUM2; af.sel_ = SEL; af.P = PBUF; af.ocmp_ = OCMP; af.owin_ = OWIN;
                AttnArgs aw = af; aw.Q = QR; aw.ldq = 1024; aw.K = PBUF + 2048; aw.V = PBUF + 2304; aw.O = OWIN; aw.ldo = 1024; aw.ocol0 = 0;
                for (int arep = 0; arep < 1 + PROBE_ATTX2; ++arep) for (;;) {
                    const int u = fetch_unit_x(ctl + 64 * 8 * (1 + 4 * arep), (int)xbar.x & 7, 64, slot);
                    if (u < 0) break;
                    const int x = u >> 6, v = u & 63;
                    if (v < 32) { const int qb = 7 - (v >> 2), bh = x + 8 * (v & 3); attn_unit<1, 128, 1>(lds, af, bh >> 3, bh & 7, qb); }
                    else { const int qb = 63 - v, bg = x; attn_unit<2, 128, 4>(lds, aw, bg >> 1, bg & 1, qb); }
                }
                TJOBQ(1, a.in[6], 2048, 11264, 11264, a.in[5], (bf16_t*)(ws + WS_W1T + (size_t)1 * 44 * MiB), ctl + 64 * 40, 6752, 11264);
            }
            GSYNC();
            {
                int tid_o = threadIdx.x; asm volatile("" : "+v"(tid_o)); const int tid = tid_o, lane = tid & 63, wave = __builtin_amdgcn_readfirstlane(tid >> 6), gw = bid * 8 + wave, gtid = bid * 512 + tid; (void)lane; (void)gw; (void)gtid;
                for (int i = gtid; i < 2 * 256 * 128 * 2; i += NGT) {
                    const int ch = i & 1, d = (i >> 1) & 127, rg = (i >> 8) & 255, kv = i >> 16;
                    const bf16_t* hp = HID + ((size_t)kv * 1024 + 4 * rg) * 256 + 128 * ch; const float* wp = a.in[12] + (size_t)kv * 256 * 128 + (size_t)(128 * ch) * 128 + d;
                    float s0 = 0.f, s1 = 0.f, s2 = 0.f, s3 = 0.f;
#pragma unroll 4
                    for (int c8 = 0; c8 < 16; ++c8) {
                        const u32x4 h0 = *(const u32x4*)(hp + 8 * c8), h1 = *(const u32x4*)(hp + 256 + 8 * c8), h2 = *(const u32x4*)(hp + 512 + 8 * c8), h3 = *(const u32x4*)(hp + 768 + 8 * c8);
#pragma unroll
                        for (int q = 0; q < 4; ++q) { const float w0 = wp[(size_t)(8 * c8 + 2 * q) * 128], w1 = wp[(size_t)(8 * c8 + 2 * q + 1) * 128];
                            s0 += bf_lo(h0[q]) * w0 + bf_hi(h0[q]) * w1; s1 += bf_lo(h1[q]) * w0 + bf_hi(h1[q]) * w1; s2 += bf_lo(h2[q]) * w0 + bf_hi(h2[q]) * w1; s3 += bf_lo(h3[q]) * w0 + bf_hi(h3[q]) * w1; }
                    }
                    s0 += __shfl_xor(s0, 1); s1 += __shfl_xor(s1, 1); s2 += __shfl_xor(s2, 1); s3 += __shfl_xor(s3, 1);
                    if (ch == 0) { bf16_t* kp = KCVC + ((size_t)kv * 1024 + 4 * rg) * 128 + d;
                        if ((rg & 31) == 31) s3 = 0.f;
                        kp[0] = (bf16_t)(pk_bf16(s0, 0.f) & 0xffffu); kp[128] = (bf16_t)(pk_bf16(s1, 0.f) & 0xffffu); kp[256] = (bf16_t)(pk_bf16(s2, 0.f) & 0xffffu); kp[384] = (bf16_t)(pk_bf16(s3, 0.f) & 0xffffu); }
                }
            }
            GSYNC();
            {
                for (int arep = 0; arep < 1 + PROBE_ATTX2; ++arep) for (;;) {
                    const int u = fetch_unit_x(ctl + 64 * 8 * (2 + 4 * arep), (int)xbar.x & 7, 32, slot);
                    if (u < 0) break;
                    const int qb = 31 - (u & 31), bg = u >> 5;
                    cmp_unit(lds, PBUF, KCVC, KCVC + (size_t)1024 * 128, OCMP, SEL, bg >> 1, bg & 1, qb);
                }
            }
            GSYNC();
            {
                AttnArgs as{}; as.Q = QR; as.ldq = 1024; as.qhs = 128; as.K = PBUF + 1536; as.ldk = HYBN; as.khs = 128; as.K2 = nullptr; as.ldk2 = 0; as.V = PBUF + 1792; as.ldv = HYBN; as.vhs = 128;
                as.O = OBUF; as.ldo = 2048; as.ocol0 = 0; as.sc2 = 0.08838834764831845f * LOG2E; as.cum2_ = CUM2; as.sel_ = SEL; as.P = PBUF; as.ocmp_ = OCMP; as.owin_ = OWIN;
                for (int arep = 0; arep < 1 + PROBE_ATTX2; ++arep) for (;;) {
                    const int u = fetch_unit_x(ctl + 64 * 8 * (3 + 4 * arep), (int)xbar.x & 7, 32, slot);
                    if (u < 0) break;
                    const int qb = 31 - (u & 31), bg = u >> 5;
                    attn_unit<3, 128, 4>(lds, as, bg >> 1, bg & 1, qb);
                }
                TJOBQ(1, a.in[2] + (size_t)2048 * 11264, 2048, 11264, 11264, a.in[1] + 2048, (bf16_t*)(ws + WS_W1T + (size_t)2 * 44 * MiB), ctl + 64 * 41, 6656, 11264);
            }
            GSYNC();
        }
        if (k == 2) {
            {
                pg8::Gemm g{XB, XB, MLAIN, M, MLAN, 2048, 2048, 1 << 30};
                pg8::StaticOrder S; S.init(M, MLAN, G, bid);
                pg8::EpiScale<8, true, 2> E{CB, MLAN, CB, MLAN, 1 << 30, SSQ, 0, 0, 1.f / 2048.f, SSQ2, ROPE64};
                pg8::gemm_phase<pg8::EpiScale<8, true, 2>, pg8::StaticOrder, true, true>(lds, g, S, E);
            }
            if (bid >= 160 && G == 256) {
                int tid_o = threadIdx.x; asm volatile("" : "+v"(tid_o)); const int lane = tid_o & 63, wave = __builtin_amdgcn_readfirstlane(tid_o >> 6);
                LAS float* scr = (LAS float*)(lds + wave * 16384);
                TJOBR(1, a.in[6] + (size_t)2048 * 11264, 2048, 11264, 11264, a.in[5] + 2048, (bf16_t*)(ws + WS_W1T + (size_t)3 * 44 * MiB), (bid - 160) * 8 + wave, 96 * 8, 1728, 9088);
            } else if (G != 256) {
                int tid_o = threadIdx.x; asm volatile("" : "+v"(tid_o)); const int lane = tid_o & 63, wave = __builtin_amdgcn_readfirstlane(tid_o >> 6);
                LAS float* scr = (LAS float*)(lds + wave * 16384);
                TJOBR(1, a.in[6] + (size_t)2048 * 11264, 2048, 11264, 11264, a.in[5] + 2048, (bf16_t*)(ws + WS_W1T + (size_t)3 * 44 * MiB), bid * 8 + wave, G * 8, 1728, 9088);
            }
            GSYNC();
            {
                pg8::Gemm g{CB, CB + 512, UQKV, M, 7168, 512, MLAN, 12};
                pg8::StaticOrder S; S.init(M, 7168, G, bid);
                pg8::EpiScale<2, false, 1> E{QBUF, 3072, KVBUF, 4096, 12, SSQ2, 0, 8, 1.f / 512.f, nullptr, ROPE64};
                pg8::gemm_phase<pg8::EpiScale<2, false, 1>, pg8::StaticOrder, true, true>(lds, g, S, E);
            }
            GSYNC();
            {
                AttnArgs am{}; am.Q = QBUF; am.ldq = 3072; am.qhs = 192; am.K = KVBUF; am.ldk = 4096; am.khs = 256; am.K2 = CB + 1024; am.ldk2 = MLAN; am.V = KVBUF + 128; am.ldv = 4096; am.vhs = 256;
                am.O = OBUF; am.ldo = 2048; am.ocol0 = 0; am.sc2 = 0.07216878364870322f * LOG2E; am.cum2_ = CUM2; am.sel_ = SEL; am.P = PBUF; am.ocmp_ = OCMP; am.owin_ = OWIN;
                for (int arep = 0; arep < 1 + PROBE_ATTX2; ++arep) for (;;) {
                    const int u = fetch_unit_x(ctl + 64 * 8 * (4 + 4 * arep), (int)xbar.x & 7, 64, slot);
                    if (u < 0) break;
                    const int x = u >> 6, v = u & 63; const int qb = 7 - (v >> 3), bh = x + 8 * (v & 7);
                    attn_unit<0, 192, 1>(lds, am, bh >> 4, bh & 15, qb);
                }
            }
            GSYNC();
        }
        if (k == 0 || k == 2) {
            pg8::Gemm g{OBUF, OBUF, k == 0 ? HYBOUT : MLAOUT, M, 2048, 2048, 2048, 1 << 30};
            pg8::StaticOrder S; S.init(M, 2048, G, bid);
            pg8::EpiResid E{X, X, XB, SSQ, 1.0f};
            pg8::gemm_phase<pg8::EpiResid, pg8::StaticOrder, true, true>(lds, g, S, E);
            GSYNC();
        }
    }
    {
                int tid_o = threadIdx.x; asm volatile("" : "+v"(tid_o)); const int tid = tid_o, lane = tid & 63, wave = __builtin_amdgcn_readfirstlane(tid >> 6), gw = bid * 8 + wave, gtid = bid * 512 + tid; (void)lane; (void)gw; (void)gtid;
    for (int m = gw; m < M; m += NGW) {
        float s = (lane < 32) ? SSQ[(size_t)m * 32 + lane] : 0.f; s = wave_sum(s);
        const float rs = rsqrtf(s * (1.f / 2048.f) + pg8::NORM_EPS);
        f32x4* xr = (f32x4*)(X + (size_t)m * D) + lane; const f32x4* gr = (const f32x4*)a.in[20] + lane;
#pragma unroll
        for (int j = 0; j < 8; ++j) { f32x4 v = xr[64 * j]; const f32x4 g4 = gr[64 * j]; v = v * rs * g4; xr[64 * j] = v; }
    }
    }    if (PROBE_TSMASK) {
        GSYNC();
        __threadfence(); __syncthreads();
        if (bid == 0) {
            const unsigned long long* ts = (const unsigned long long*)(a.ws + 65536); unsigned long long tot = 0;
            for (int n = 1; n <= 22; ++n) if ((PROBE_TSMASK >> n) & 1u) tot += ts[n] - ts[n - 1];
            if ((PROBE_TSMASK >> 23) & 1u) tot += ts[0] - ts[23];
            const float code = (float)tot * 10.0f;
            const float delta = sqrtf(code * 1.0246e-8f);
            for (int i = threadIdx.x; i < 16384; i += 512) X[i] += delta;
        }
    }
}

extern "C" void kernel_launch(void* const* d_in, const int* in_sizes, int n_in, void* d_out, int out_size, void* d_ws, size_t ws_size, hipStream_t stream) {
    static int grid = 0;
    if (grid == 0) {
        if (n_in != 21 || ws_size < WS_END) { fprintf(stderr, "kernel_launch: unexpected n_in %d or ws %zu (< %zu)\n", n_in, ws_size, (size_t)WS_END); grid = -1; return; }
        int dev = 0, cus = 0, per_cu = 0;
        hipGetDevice(&dev); hipDeviceGetAttribute(&cus, hipDeviceAttributeMultiprocessorCount, dev);
        if (hipFuncSetAttribute((const void*)mega_fwd, hipFuncAttributeMaxDynamicSharedMemorySize, LDS_BYTES) != hipSuccess) { fprintf(stderr, "hipFuncSetAttribute failed\n"); grid = -1; return; }
        if (hipOccupancyMaxActiveBlocksPerMultiprocessor(&per_cu, (const void*)mega_fwd, 512, LDS_BYTES) != hipSuccess || per_cu < 1) { fprintf(stderr, "occupancy query: %d\n", per_cu); per_cu = 1; }
        (void)hipGetLastError();
        grid = cus * 1;
    }
    if (grid < 0) return;
    if (hipMemsetAsync(d_ws, 0, 65536, stream) != hipSuccess) { fprintf(stderr, "memset of control words failed\n"); return; }
    Args a{};
    for (int i = 0; i < 21; ++i) a.in[i] = (const float*)d_in[i];
    a.out = (float*)d_out; a.ws = (unsigned char*)d_ws;
    void* args[] = {&a};
    hipError_t e = hipLaunchCooperativeKernel((const void*)mega_fwd, dim3(grid), dim3(512), args, LDS_BYTES, stream);
    if (e != hipSuccess) fprintf(stderr, "cooperative launch failed: %s (grid %d)\n", hipGetErrorString(e), grid);
}
```

```cpp
#include <hip/hip_runtime.h>
#include <hip/hip_cooperative_groups.h>
#include <cstdio>
#include <cstdint>
namespace cg = cooperative_groups;
#ifndef PROBE_SYNC2
#define PROBE_SYNC2 0
#endif
#ifndef PROBE_TSMASK
#define PROBE_TSMASK 0u
#endif
#ifndef PROBE_UPX2
#define PROBE_UPX2 0
#endif
#ifndef PROBE_ATTX2
#define PROBE_ATTX2 0
#endif
#ifndef PROBE_P0X2
#define PROBE_P0X2 0
#endif
#define GSYNC() do { xcd_barrier(xbar); if (PROBE_SYNC2) xcd_barrier(xbar); if (PROBE_TSMASK) { ++ts_idx; if (blockIdx.x == 0 && threadIdx.x == 0) ((unsigned long long*)(a.ws + 65536))[ts_idx] = __builtin_amdgcn_s_memrealtime(); } } while (0)
namespace pg8 {
#define PG8_LAS __attribute__((address_space(3)))
typedef unsigned short bf16_t;
typedef short bf16x8 __attribute__((ext_vector_type(8)));
typedef float f32x4 __attribute__((ext_vector_type(4)));
typedef unsigned u32x4 __attribute__((ext_vector_type(4)));
constexpr int BM = 256, BK = 64, HALF = 128, HTB = HALF * BK * 2  , STAGE_BYTES = 8 * HTB, NXCD = 8, WGM = 8;

__host__ __device__ __forceinline__ int lds_byte(int r, int c) { const int st = (r >> 4) * 2 + (c >> 5), rr = r & 15, cc = c & 31, ob = rr * 64 + cc * 2; return st * 1024 + (ob ^ (((ob >> 9) & 1) << 5)); }
__host__ __device__ __forceinline__ void stage_rc(int b, int& R, int& C) { const int st = b / 1024, sb = b % 1024, swz = sb ^ (((sb >> 9) & 1) << 5); R = (st >> 1) * 16 + swz / 64; C = (st & 1) * 32 + (swz % 64) / 2; }
__host__ __device__ __forceinline__ int perm32(int rho) { const int n = rho >> 4, i = rho & 15; return 8 * (i >> 2) + 4 * n + (i & 3); }

struct Unit { int pm, pn; };

struct StaticOrder {
    int nM, nN, nwg, G, c;
    __host__ __device__ void init(int M, int N, int G_, int c_) { nM = M / BM; nN = N / BM; nwg = nM * nN; G = G_; c = c_; }
    __host__ __device__ bool next(int i, Unit& u) const {
        const long L = (long)i * G + c; if (L >= nwg) return false;
        int wgid = (int)L; { const int q = nwg / NXCD, r = nwg % NXCD, xcd = wgid % NXCD, off = wgid / NXCD; wgid = (xcd < r ? xcd * (q + 1) : r * (q + 1) + (xcd - r) * q) + off; }
        const int nig = WGM * nN, gid = wgid / nig, fm = gid * WGM, gsz = (nM - fm) < WGM ? (nM - fm) : WGM;
        u.pm = fm + ((wgid % nig) % gsz); u.pn = (wgid % nig) / gsz; return true;
    }
    __device__ __forceinline__ void a_ready(const Unit&) const {}
    __device__ __forceinline__ void done(const Unit&) const {}
};

struct Gemm { const bf16_t* A; const bf16_t* A2; const bf16_t* Bt; int M, N, K, lda, pn2; };
struct ListOrder {
    int nM, nwg, G, c;
    __device__ void init(int M, int N, int G_, int c_) { nM = M / BM; nwg = nM * (N / BM); G = G_; c = c_; }
    __device__ bool next(int i, Unit& u) const { const long L = (long)i * G + c; if (L >= nwg) return false; u.pm = (int)L % nM; u.pn = (int)L / nM; return true; }
    __device__ __forceinline__ void a_ready(const Unit&) const {}
    __device__ __forceinline__ void done(const Unit&) const {}
};
typedef __bf16 bf16x2v __attribute__((ext_vector_type(2)));
typedef float f32x2v __attribute__((ext_vector_type(2)));
typedef unsigned u32x2 __attribute__((ext_vector_type(2)));
__device__ __forceinline__ unsigned pk_bf16(float lo, float hi) { f32x2v f = {lo, hi}; return __builtin_bit_cast(unsigned, __builtin_convertvector(f, bf16x2v)); }
__device__ __forceinline__ float bf_lo(unsigned u) { return __uint_as_float(u << 16); }
__device__ __forceinline__ float bf_hi(unsigned u) { return __uint_as_float(u & 0xffff0000u); }
__device__ __forceinline__ float bf2f(bf16_t v) { return __uint_as_float(((unsigned)v) << 16); }

constexpr float NORM_EPS = 1e-6f;
template <int PER> __device__ __forceinline__ float row_rstd(const float* ssq, int off, float invn, int row, int fq) {
    const float* p = ssq + (size_t)row * 32 + off + fq * PER; float s = 0.f;
#pragma unroll
    for (int i = 0; i < PER; ++i) s += p[i];
    s += __shfl_xor(s, 16); s += __shfl_xor(s, 32);
    return rsqrtf(s * invn + NORM_EPS);
}
__device__ __forceinline__ float silu_f(float g) { return g * __builtin_amdgcn_rcpf(1.f + __expf(-g)); }
__device__ __forceinline__ float gelu_tanh_f(float x) { const float u = 0.7978845608028654f * (x + 0.044715f * x * x * x); const float e = __expf(2.f * u); const float th = 1.f - 2.f * __builtin_amdgcn_rcpf(1.f + e); return 0.5f * x * (1.f + th); }

struct EpiSwiglu {
    static constexpr bool PERM = true, AFTER_DRAIN = false;
    bf16_t* O; int ldc; const float* ssq;
    __device__ __forceinline__ void operator()(const f32x4 (&acc)[2][2][4][2], const Unit& u, int wr, int wc, int fr, int fq) const {
        const int row0 = u.pm * BM + wr * 64 + fr, col0 = u.pn * 128 + wc * 32 + 8 * fq;
        float rsv[2][4];
#pragma unroll
        for (int ai = 0; ai < 2; ++ai)
#pragma unroll
            for (int m = 0; m < 4; ++m) rsv[ai][m] = row_rstd<8>(ssq, 0, 1.f / 2048.f, row0 + ai * HALF + m * 16, fq);
#pragma unroll
        for (int ai = 0; ai < 2; ++ai)
#pragma unroll
            for (int m = 0; m < 4; ++m) {
                const int row = row0 + ai * HALF + m * 16; const float rs = rsv[ai][m];
                f32x4 v0, v1;
#pragma unroll
                for (int j = 0; j < 4; ++j) { v0[j] = silu_f(acc[ai][0][m][0][j] * rs) * (acc[ai][1][m][0][j] * rs); v1[j] = silu_f(acc[ai][0][m][1][j] * rs) * (acc[ai][1][m][1][j] * rs); }
                u32x4 w; w.x = pk_bf16(v0[0], v0[1]); w.y = pk_bf16(v0[2], v0[3]); w.z = pk_bf16(v1[0], v1[1]); w.w = pk_bf16(v1[2], v1[3]);
                *(u32x4*)(O + (size_t)row * ldc + col0) = w;
            }
    }
};
template <int PER, bool SSQ_OUT, int ROPE = 0> struct EpiScale {
    static constexpr bool PERM = true, AFTER_DRAIN = false;
    bf16_t* O; int ldc; bf16_t* O2; int ldc2; int pn2; const float* ssq; int soff, soff2; float invn; float* ssq_out; const float* rope;
    __device__ __forceinline__ void operator()(const f32x4 (&acc)[2][2][4][2], const Unit& u, int wr, int wc, int fr, int fq) const {
        const int row0 = u.pm * BM + wr * 64 + fr; const bool second = u.pn >= pn2;
        bf16_t* base = second ? O2 : O; const int ld = second ? ldc2 : ldc; const int so = second ? soff2 : soff;
        const int col0 = (second ? u.pn - pn2 : u.pn) * BM + wc * 32 + 8 * fq;
        float rsv[2][4];
#pragma unroll
        for (int ai = 0; ai < 2; ++ai)
#pragma unroll
            for (int m = 0; m < 4; ++m) rsv[ai][m] = row_rstd<PER>(ssq, so, invn, row0 + ai * HALF + m * 16, fq);
#pragma unroll
        for (int ai = 0; ai < 2; ++ai)
#pragma unroll
            for (int m = 0; m < 4; ++m) {
                const int row = row0 + ai * HALF + m * 16; const float rs = rsv[ai][m];
                float sq = 0.f;
#pragma unroll
                for (int bj = 0; bj < 2; ++bj) { f32x4 v0 = acc[ai][bj][m][0] * rs, v1 = acc[ai][bj][m][1] * rs;
                    if (ROPE != 0) { const int cc = col0 + bj * HALF; int i0 = -1;
                        if (ROPE == 1) { if (!second) { const int c192 = cc % 192; if (c192 >= 128) i0 = (c192 - 128) >> 1; } }
                        else { if (cc >= 1024 && cc < 1088) i0 = (cc - 1024) >> 1; }
                        if (i0 >= 0) { const float* rp = rope + ((size_t)(row & 2047) * 32 + i0) * 2; const f32x4 c0 = *(const f32x4*)rp, c1 = *(const f32x4*)(rp + 4);
                            const f32x4 a0 = v0, a1 = v1;
                            v0[0] = a0[0] * c0[0] - a0[1] * c0[1]; v0[1] = a0[1] * c0[0] + a0[0] * c0[1]; v0[2] = a0[2] * c0[2] - a0[3] * c0[3]; v0[3] = a0[3] * c0[2] + a0[2] * c0[3];
                            v1[0] = a1[0] * c1[0] - a1[1] * c1[1]; v1[1] = a1[1] * c1[0] + a1[0] * c1[1]; v1[2] = a1[2] * c1[2] - a1[3] * c1[3]; v1[3] = a1[3] * c1[2] + a1[2] * c1[3]; } }
                    if (SSQ_OUT) sq += (v0[0] * v0[0] + v0[1] * v0[1]) + (v0[2] * v0[2] + v0[3] * v0[3]) + (v1[0] * v1[0] + v1[1] * v1[1]) + (v1[2] * v1[2] + v1[3] * v1[3]);
                    u32x4 w; w.x = pk_bf16(v0[0], v0[1]); w.y = pk_bf16(v0[2], v0[3]); w.z = pk_bf16(v1[0], v1[1]); w.w = pk_bf16(v1[2], v1[3]);
                    *(u32x4*)(base + (size_t)row * ld + col0 + bj * HALF) = w; }
                if (SSQ_OUT) { sq += __shfl_xor(sq, 16); sq += __shfl_xor(sq, 32); if (fq == 0) ssq_out[(size_t)row * 32 + u.pn * 4 + wc] = sq; }
            }
    }
};
struct EpiResid {
    static constexpr bool PERM = false, AFTER_DRAIN = false;
    const float* base; float* out; bf16_t* xb; float* ssq; float c;
    __device__ __forceinline__ void operator()(const f32x4 (&acc)[2][2][4][2], const Unit& u, int wr, int wc, int fr, int fq) const {
        const int row0 = u.pm * BM + wr * 64 + fr, col0 = u.pn * BM + wc * 32 + 4 * fq;
        f32x4 bv[8][2][2];
#define RES_LD(g) do { const size_t ro_ = (size_t)(row0 + ((g) >> 2) * HALF + ((g) & 3) * 16) * 2048 + col0; \
        _Pragma("unroll") for (int bj = 0; bj < 2; ++bj) _Pragma("unroll") for (int n = 0; n < 2; ++n) bv[g][bj][n] = *(const f32x4*)(base + ro_ + bj * HALF + n * 16); } while (0)
        RES_LD(0); RES_LD(1); RES_LD(2);
#pragma unroll
        for (int g = 0; g < 8; ++g) {
            const int ai = g >> 2, m = g & 3; const int row = row0 + ai * HALF + m * 16; float sq = 0.f;
#pragma unroll
            for (int bj = 0; bj < 2; ++bj)
#pragma unroll
                for (int n = 0; n < 2; ++n) { const size_t off = (size_t)row * 2048 + col0 + bj * HALF + n * 16;
                    const f32x4 v = bv[g][bj][n] + acc[ai][bj][m][n] * c;
                    *(f32x4*)(out + off) = v; sq += (v[0] * v[0] + v[1] * v[1]) + (v[2] * v[2] + v[3] * v[3]);
                    u32x2 w; w.x = pk_bf16(v[0], v[1]); w.y = pk_bf16(v[2], v[3]); *(u32x2*)(xb + off) = w; }
            sq += __shfl_xor(sq, 16); sq += __shfl_xor(sq, 32); if (fq == 0) ssq[(size_t)row * 32 + u.pn * 4 + wc] = sq;
            if (g + 3 < 8) { switch (g + 3) { case 3: RES_LD(3); break; case 4: RES_LD(4); break; case 5: RES_LD(5); break; case 6: RES_LD(6); break; default: RES_LD(7); break; } }
        }
#undef RES_LD
    }
};
struct EpiGelu {
    static constexpr bool PERM = true, AFTER_DRAIN = false;
    bf16_t* HID; const float* bias;
    __device__ __forceinline__ void operator()(const f32x4 (&acc)[2][2][4][2], const Unit& u, int wr, int wc, int fr, int fq) const {
        const int row0 = u.pm * BM + wr * 64 + fr, col0 = wc * 32 + 8 * fq;
        f32x4 bb[2][2];
#pragma unroll
        for (int bj = 0; bj < 2; ++bj) { const float* bp = bias + u.pn * 256 + col0 + bj * HALF; bb[bj][0] = *(const f32x4*)bp; bb[bj][1] = *(const f32x4*)(bp + 4); }
#pragma unroll
        for (int ai = 0; ai < 2; ++ai)
#pragma unroll
            for (int m = 0; m < 4; ++m) { const int row = row0 + ai * HALF + m * 16;
#pragma unroll
                for (int bj = 0; bj < 2; ++bj) { float v[8];
#pragma unroll
                    for (int j = 0; j < 4; ++j) { v[j] = gelu_tanh_f(acc[ai][bj][m][0][j] + bb[bj][0][j]); v[4 + j] = gelu_tanh_f(acc[ai][bj][m][1][j] + bb[bj][1][j]); }
                    u32x4 w; w.x = pk_bf16(v[0], v[1]); w.y = pk_bf16(v[2], v[3]); w.z = pk_bf16(v[4], v[5]); w.w = pk_bf16(v[6], v[7]);
                    *(u32x4*)(HID + ((size_t)u.pn * 1024 + row) * 256 + col0 + bj * HALF) = w; } }
    }
};
template <class Epi, class Sched, bool ALIGN_EPI = false, bool SP2 = false>
__device__ __forceinline__ void gemm_phase(PG8_LAS unsigned char* lds, const Gemm g, const Sched& S, const Epi& E) {
    int tid_op = threadIdx.x; asm volatile("" : "+v"(tid_op));
    const int tid = tid_op, wid = __builtin_amdgcn_readfirstlane(tid >> 6), lane = tid & 63, wr = wid >> 2, wc = wid & 3, fr = lane & 15, fq = lane >> 4;
    const int K = g.K, nt = K / BK;
    unsigned voffA[2], voffB[2];
#pragma unroll
    for (int i = 0; i < 2; ++i) { int R, C; stage_rc(tid * 16 + i * 8192, R, C); const int Rb = Epi::PERM ? ((R & ~31) + perm32(R & 31)) : R;
        voffA[i] = (unsigned)(R * g.lda + C) * 2u; voffB[i] = (unsigned)(Rb * K + C) * 2u; }
    const size_t kstep = (size_t)(BK * 2);
    const size_t hstepB = (size_t)HALF * K * 2, hstepA = (size_t)HALF * g.lda * 2;
    const size_t tstepA = 2 * hstepA, tstepB = 2 * hstepB;
    const unsigned ldsw = (unsigned)wid * 1024u;
    const int aoff = lds_byte(wr * 64 + fr, fq * 8), boff = lds_byte(wc * 32 + fr, fq * 8);
#define PG8_SA(b, h) (((b) * 2 + (h)) * HTB)
#define PG8_SB(b, h) ((4 + (b) * 2 + (h)) * HTB)
#define PG8_STAGE(bufoff, gbase, voff) do { _Pragma("unroll") for (int _i = 0; _i < 2; ++_i) \
        __builtin_amdgcn_global_load_lds((const unsigned*)((const char*)(gbase) + (voff)[_i]), (PG8_LAS unsigned*)(lds + (bufoff) + ldsw + _i * 8192), 16, 0, 0); } while (0)
#define PG8_LDA(dst, b, h) do { _Pragma("unroll") for (int m = 0; m < 4; ++m) _Pragma("unroll") for (int k = 0; k < 2; ++k) dst[m][k] = *(const PG8_LAS bf16x8*)(lds + PG8_SA(b, h) + aoff + m * 2048 + k * 1024); } while (0)
#define PG8_LDB(dst, b, h) do { _Pragma("unroll") for (int n = 0; n < 2; ++n) _Pragma("unroll") for (int k = 0; k < 2; ++k) dst[n][k] = *(const PG8_LAS bf16x8*)(lds + PG8_SB(b, h) + boff + n * 2048 + k * 1024); } while (0)
#define PG8_MMA(ai, bj, At, Bt) do { __builtin_amdgcn_s_setprio(1); _Pragma("unroll") for (int m = 0; m < 4; ++m) _Pragma("unroll") for (int n = 0; n < 2; ++n) _Pragma("unroll") for (int k = 0; k < 2; ++k) \
        acc[ai][bj][m][n] = __builtin_amdgcn_mfma_f32_16x16x32_bf16(Bt[n][k], At[m][k], acc[ai][bj][m][n], 0, 0, 0); __builtin_amdgcn_s_setprio(0); } while (0)
#define PG8_WAIT_V(n) asm volatile("s_waitcnt vmcnt(" #n ")" ::: "memory")
#define PG8_WAIT_L(n) asm volatile("s_waitcnt lgkmcnt(" #n ")" ::: "memory")
#define PG8_BAR __builtin_amdgcn_s_barrier()
#define PG8_SCHED __builtin_amdgcn_sched_barrier(0)
    Unit cur, nxt; int ui = 0;
    if (!S.next(0, cur)) return;
    f32x4 acc[2][2][4][2];
#pragma unroll
    for (int a = 0; a < 2; ++a)
#pragma unroll
        for (int b = 0; b < 2; ++b)
#pragma unroll
            for (int m = 0; m < 4; ++m)
#pragma unroll
                for (int n = 0; n < 2; ++n) acc[a][b][m][n] = (f32x4){0.f, 0.f, 0.f, 0.f};
    bf16x8 At[4][2], B0[2][2], B1[2][2];
    const char* cA = (const char*)(cur.pn >= g.pn2 ? g.A2 : g.A) + (size_t)cur.pm * tstepA; const char* cB = (const char*)g.Bt + (size_t)cur.pn * tstepB;
    S.a_ready(cur);
    if constexpr (SP2) {
        PG8_STAGE(PG8_SB(0, 0), cB, voffB); PG8_STAGE(PG8_SB(0, 1), cB + hstepB, voffB); PG8_STAGE(PG8_SA(0, 0), cA, voffA); PG8_STAGE(PG8_SA(0, 1), cA + hstepA, voffA);
        if (wr == 1) PG8_BAR;
        PG8_WAIT_V(2); PG8_BAR;
        PG8_STAGE(PG8_SB(1, 0), cB + kstep, voffB); PG8_STAGE(PG8_SA(1, 0), cA + kstep, voffA); PG8_STAGE(PG8_SB(1, 1), cB + hstepB + kstep, voffB);
        PG8_WAIT_V(6); PG8_BAR;
    } else {
        PG8_STAGE(PG8_SB(0, 0), cB, voffB); PG8_STAGE(PG8_SA(0, 0), cA, voffA); PG8_STAGE(PG8_SB(0, 1), cB + hstepB, voffB); PG8_STAGE(PG8_SA(0, 1), cA + hstepA, voffA);
        if (wr == 1) PG8_BAR;
        PG8_WAIT_V(4); PG8_BAR;
        PG8_STAGE(PG8_SB(1, 0), cB + kstep, voffB); PG8_STAGE(PG8_SA(1, 0), cA + kstep, voffA); PG8_STAGE(PG8_SB(1, 1), cB + hstepB + kstep, voffB);
        PG8_WAIT_V(6); PG8_BAR;
    }
    for (;;) {
        const bool has_next = S.next(ui + 1, nxt);
        const char* nA = has_next ? (const char*)(nxt.pn >= g.pn2 ? g.A2 : g.A) + (size_t)nxt.pm * tstepA : cA; const char* nB = has_next ? (const char*)g.Bt + (size_t)nxt.pn * tstepB : cB;
        for (int t = 0; t < nt; t += 2) {
            const bool last = (t == nt - 2);
            const char* a1 = cA + (size_t)(t + 1) * kstep;
            const char* a2 = last ? nA : cA + (size_t)(t + 2) * kstep; const char* b2 = last ? nB : cB + (size_t)(t + 2) * kstep;
            const char* a3 = a2 + kstep; const char* b3 = b2 + kstep;
            if (last && has_next) S.a_ready(nxt);
            if constexpr (SP2) {
            PG8_LDB(B0, 0, 0); PG8_LDB(B1, 0, 1); PG8_SCHED; PG8_LDA(At, 0, 0); PG8_STAGE(PG8_SA(1, 1), a1 + hstepA, voffA);
            PG8_WAIT_V(8); PG8_WAIT_L(0); PG8_BAR; PG8_MMA(0, 0, At, B0); PG8_MMA(0, 1, At, B1); PG8_BAR; PG8_SCHED;
            PG8_LDA(At, 0, 1); PG8_STAGE(PG8_SB(0, 0), b2, voffB); PG8_STAGE(PG8_SB(0, 1), b2 + hstepB, voffB); PG8_STAGE(PG8_SA(0, 0), a2, voffA);
            PG8_WAIT_V(8); PG8_WAIT_L(0); PG8_BAR; PG8_MMA(1, 0, At, B0); PG8_MMA(1, 1, At, B1); PG8_BAR; PG8_SCHED;
            PG8_LDB(B0, 1, 0); PG8_LDB(B1, 1, 1); PG8_SCHED; PG8_LDA(At, 1, 0); PG8_STAGE(PG8_SA(0, 1), a2 + hstepA, voffA);
            PG8_WAIT_V(8); PG8_WAIT_L(0); PG8_BAR; PG8_MMA(0, 0, At, B0); PG8_MMA(0, 1, At, B1); PG8_BAR; PG8_SCHED;
            PG8_LDA(At, 1, 1); PG8_STAGE(PG8_SB(1, 0), b3, voffB); PG8_STAGE(PG8_SB(1, 1), b3 + hstepB, voffB); PG8_STAGE(PG8_SA(1, 0), a3, voffA);
            PG8_WAIT_V(8); PG8_WAIT_L(0); PG8_BAR; PG8_MMA(1, 0, At, B0); PG8_MMA(1, 1, At, B1); PG8_BAR; PG8_SCHED;
            } else {
            PG8_LDB(B0, 0, 0); PG8_SCHED; PG8_LDA(At, 0, 0); PG8_STAGE(PG8_SA(1, 1), a1 + hstepA, voffA);
            PG8_WAIT_L(8); PG8_BAR; PG8_WAIT_L(0); PG8_MMA(0, 0, At, B0); PG8_BAR; PG8_SCHED;
            PG8_LDB(B1, 0, 1); PG8_STAGE(PG8_SB(0, 0), b2, voffB);
            PG8_BAR; PG8_WAIT_L(0); PG8_MMA(0, 1, At, B1); PG8_BAR;
            PG8_LDA(At, 0, 1); PG8_STAGE(PG8_SA(0, 0), a2, voffA);
            PG8_BAR; PG8_WAIT_L(0); PG8_MMA(1, 0, At, B0); PG8_BAR; PG8_SCHED;
            PG8_STAGE(PG8_SB(0, 1), b2 + hstepB, voffB);
            PG8_WAIT_V(6); PG8_BAR; PG8_MMA(1, 1, At, B1); PG8_BAR;
            PG8_LDB(B0, 1, 0); PG8_SCHED; PG8_LDA(At, 1, 0); PG8_STAGE(PG8_SA(0, 1), a2 + hstepA, voffA);
            PG8_WAIT_L(8); PG8_BAR; PG8_WAIT_L(0); PG8_MMA(0, 0, At, B0); PG8_BAR; PG8_SCHED;
            PG8_LDB(B1, 1, 1); PG8_STAGE(PG8_SB(1, 0), b3, voffB);
            PG8_BAR; PG8_WAIT_L(0); PG8_MMA(0, 1, At, B1); PG8_BAR;
            PG8_LDA(At, 1, 1); PG8_STAGE(PG8_SA(1, 0), a3, voffA);
            PG8_BAR; PG8_WAIT_L(0); PG8_MMA(1, 0, At, B0); PG8_BAR; PG8_SCHED;
            PG8_STAGE(PG8_SB(1, 1), b3 + hstepB, voffB);
            PG8_WAIT_V(6); PG8_BAR; PG8_MMA(1, 1, At, B1); PG8_BAR;
            }
        }
        if constexpr (ALIGN_EPI) { if (wr == 0) PG8_BAR; }
        if constexpr (!Epi::AFTER_DRAIN) { E(acc, cur, wr, wc, fr, fq); S.done(cur); }
        if (!has_next) break;
#pragma unroll
        for (int a = 0; a < 2; ++a)
#pragma unroll
            for (int b = 0; b < 2; ++b)
#pragma unroll
                for (int m = 0; m < 4; ++m)
#pragma unroll
                    for (int n = 0; n < 2; ++n) acc[a][b][m][n] = (f32x4){0.f, 0.f, 0.f, 0.f};
        cur = nxt; cA = nA; cB = nB; ++ui;
        if constexpr (ALIGN_EPI) { if (wr == 1) PG8_BAR; }
    }
    PG8_WAIT_V(0);
    if constexpr (!ALIGN_EPI) { if (wr == 0) PG8_BAR; }
    PG8_BAR;
    if constexpr (Epi::AFTER_DRAIN) { E.fused(acc, cur, wr, wc, fr, fq, lds, wid, lane); S.done(cur); }
#undef PG8_SA
#undef PG8_SB
#undef PG8_STAGE
#undef PG8_LDA
#undef PG8_LDB
#undef PG8_MMA
#undef PG8_WAIT_V
#undef PG8_WAIT_L
#undef PG8_BAR
#undef PG8_SCHED
}
}
#define LAS __attribute__((address_space(3)))
typedef unsigned short bf16_t;
typedef short bf16x8 __attribute__((ext_vector_type(8)));
typedef short s16x4 __attribute__((ext_vector_type(4)));
typedef float f32x4 __attribute__((ext_vector_type(4)));
typedef float f32x16 __attribute__((ext_vector_type(16)));
typedef unsigned u32x4 __attribute__((ext_vector_type(4)));
using pg8::u32x2; using pg8::pk_bf16; using pg8::bf_lo; using pg8::bf_hi; using pg8::bf2f;
constexpr int T = 2048, NB = 4, M = NB * T, D = 2048, DFF = 5632, HYBN = 5888, MLAN = 1280;
constexpr size_t MiB = 1u << 20;
constexpr size_t WS_CTL = 0, WS_SSQ = 1 * MiB, WS_SSQ2 = 2 * MiB, WS_CUM = 3 * MiB, WS_SEL = 3 * MiB + 256 * 1024, WS_BPART = 3 * MiB + 512 * 1024, WS_BIASPE = 3 * MiB + 768 * 1024,
                 WS_ROPE128 = 4 * MiB, WS_ROPE64 = 5 * MiB, WS_HID = 6 * MiB, WS_KCVC = 7 * MiB;
constexpr size_t WS_W1T = 8 * MiB, WS_W2T = 184 * MiB, WS_HYBIN = 272 * MiB, WS_HYBOUT = 295 * MiB, WS_MLAIN = 303 * MiB, WS_UQKV = 308 * MiB, WS_MLAOUT = 315 * MiB, WS_CMPW1 = 323 * MiB;
constexpr size_t WS_XB = 327 * MiB, WS_ACT = 359 * MiB, WS_OBUF = 447 * MiB, WS_MIX = 479 * MiB;
constexpr size_t WS_PBUF = WS_MIX, WS_QR = WS_MIX + 92 * MiB, WS_CMPIN = WS_MIX + 108 * MiB, WS_OWIN = WS_MIX + 117 * MiB, WS_OCMP = WS_MIX + 133 * MiB;
constexpr size_t WS_C = WS_MIX, WS_QBUF = WS_MIX + 20 * MiB, WS_KVBUF = WS_MIX + 68 * MiB;
constexpr size_t WS_END = WS_MIX + 149 * MiB;
constexpr int LDS_BYTES = 147456, MISC_OFF = 131072;
constexpr float LOG2E = 1.4426950408889634f;

struct Args { const float* in[21]; float* out; unsigned char* ws; };

__device__ __forceinline__ float wave_sum(float v) {
#pragma unroll
    for (int o = 1; o < 64; o <<= 1) v += __shfl_xor(v, o);
    return v;
}
template <int MODE> __device__ __forceinline__ int mapcol(int n, int N) {
    if (MODE == 0) return n < N ? n : -1;
    if (MODE == 1) { const int t = n >> 8, r = n & 255; return r < 128 ? 128 * t + r : DFF + 128 * t + (r - 128); }
    if (MODE == 2) { if (n < 2560) return n; if (n < 5632) return n + 24; if (n < 5656) return 2560 + (n - 5632); if (n < 5664) return n; return -1; }
    if (MODE == 3) { const int h = n / 192, c = n % 192; if (c < 128) return n; const int p = c - 128; return h * 192 + 128 + (p >> 1) + 32 * (p & 1); }
    if (MODE == 4) { if (n < 1024) return n; if (n < 1088) { const int p = n - 1024; return 1024 + (p >> 1) + 32 * (p & 1); } return -1; }
    return -1;
}
template <int MODE> __device__ __forceinline__ void transpose_item(const float* W, int K, int N, int NP, const float* gain, bf16_t* WT, LAS float* scr, int item, int lane) {
    const int nblk = NP / 32, kb = item / nblk, nb = item % nblk, k0 = 64 * kb, n0 = 32 * nb;
    const int sc = mapcol<MODE>(n0 + (lane & 31), N);
    float v[32];
#pragma unroll
    for (int i = 0; i < 32; ++i) { const int kk = 2 * i + (lane >> 5); v[i] = (sc >= 0) ? W[(size_t)(k0 + kk) * N + sc] : 0.f; }
    if (gain) {
#pragma unroll
        for (int i = 0; i < 32; ++i) v[i] *= gain[k0 + 2 * i + (lane >> 5)]; }
#pragma unroll
    for (int i = 0; i < 32; ++i) scr[(2 * i + (lane >> 5)) * 33 + (lane & 31)] = v[i];
    asm volatile("s_waitcnt lgkmcnt(0)" ::: "memory");
    const int c = lane & 7;
#pragma unroll
    for (int j = 0; j < 4; ++j) { const int n = (lane >> 3) + 8 * j; const LAS float* s = scr + (8 * c) * 33 + n;
        u32x4 o; o.x = pk_bf16(s[0 * 33], s[1 * 33]); o.y = pk_bf16(s[2 * 33], s[3 * 33]); o.z = pk_bf16(s[4 * 33], s[5 * 33]); o.w = pk_bf16(s[6 * 33], s[7 * 33]);
        *(u32x4*)(WT + (size_t)(n0 + n) * K + k0 + 8 * c) = o; }
    asm volatile("s_waitcnt lgkmcnt(0)" ::: "memory");
}
#define XB_TMO      128
#define XB_XCNT(j)  (256  + 64 * (j))
#define XB_XSUB(j)  (1280 + 64 * (j))
#define XB_XGEN(j)  (2304 + 64 * (j))
#define XB_TOP      3328
#define XB_TOPGEN   3392
#define XCD_BAR_WORDS 3456
#define XB_SPIN_CAP (1u << 18)

__device__ __forceinline__ unsigned xb_ld(unsigned* p)              { return __hip_atomic_load(p, __ATOMIC_RELAXED, __HIP_MEMORY_SCOPE_AGENT); }
__device__ __forceinline__ unsigned xb_add(unsigned* p, unsigned v) { return __hip_atomic_fetch_add(p, v, __ATOMIC_RELAXED, __HIP_MEMORY_SCOPE_AGENT); }
__device__ __forceinline__ unsigned xb_xcc_id() { return (unsigned)__builtin_amdgcn_s_getreg((3 << 11) | 20) & 0xFu; }
#define XB_SPIN(cond, bar) do { unsigned _sp = 0; while (cond) { __builtin_amdgcn_s_sleep(1); \
    if ((++_sp & 255u) == 0u) { if (xb_ld(&(bar)[XB_TMO])) break; if (_sp > XB_SPIN_CAP) { atomicAdd(&(bar)[XB_TMO], 1u); break; } } } } while (0)

struct XcdBarrier {
    unsigned* bar; unsigned x;
    volatile LAS unsigned* st;
};

__device__ __forceinline__ XcdBarrier xcd_barrier_post(unsigned* bar, volatile LAS unsigned* st) {
    XcdBarrier b; b.bar = bar; b.x = xb_xcc_id(); b.st = st;
    if (threadIdx.x == 0) (void)xb_add(&bar[XB_XCNT(b.x)], 1u);
    return b;
}
__device__ __forceinline__ void xcd_barrier_complete(unsigned* bar, unsigned x, unsigned& nloc, unsigned& nx) {
    const unsigned G = gridDim.x * gridDim.y * gridDim.z;
    unsigned sum, cnt, mine, sp = 0u;
    for (;;) {
        sum = 0u; cnt = 0u; mine = 0u;
#pragma unroll
        for (unsigned j = 0; j < 16; ++j) { const unsigned c = xb_ld(&bar[XB_XCNT(j)]); sum += c; cnt += (c > 0u) ? 1u : 0u; mine = (j == x) ? c : mine; }
        if (sum == G) break;
        __builtin_amdgcn_s_sleep(1);
        if ((++sp & 255u) == 0u) { if (xb_ld(&bar[XB_TMO])) break; if (sp > XB_SPIN_CAP) { atomicAdd(&bar[XB_TMO], 1u); break; } }
    }
    nloc = mine > 0u ? mine : 1u; nx = cnt > 0u ? cnt : 1u;
}

__device__ __forceinline__ void xcd_barrier(const XcdBarrier& b) {
    asm volatile("s_waitcnt vmcnt(0)" ::: "memory");
    __syncthreads();
    if (threadIdx.x == 0) {
        unsigned* bar = b.bar; unsigned xx = __builtin_amdgcn_readfirstlane(b.x); asm volatile("" : "+s"(xx));
        __builtin_amdgcn_s_waitcnt(0);
        unsigned nloc = b.st[0], nx = b.st[1];
        if (nloc == 0u) { xcd_barrier_complete(bar, xx, nloc, nx); b.st[0] = nloc; b.st[1] = nx; }
        const unsigned old = xb_add(&bar[XB_XSUB(xx)], 1u);
        const unsigned gen = old / nloc;
        if (old + 1u == (gen + 1u) * nloc) {
            __builtin_amdgcn_fence(__ATOMIC_RELEASE, "agent");
            asm volatile("s_waitcnt vmcnt(0)" ::: "memory");
            const unsigned og = xb_add(&bar[XB_TOP], 1u);
            const unsigned tg = og / nx;
            if (og + 1u == (tg + 1u) * nx) xb_add(&bar[XB_TOPGEN], 1u);
            else XB_SPIN(xb_ld(&bar[XB_TOPGEN]) == tg, bar);
            __builtin_amdgcn_fence(__ATOMIC_ACQUIRE, "agent");
            xb_add(&bar[XB_XGEN(xx)], 1u);
            asm volatile("s_waitcnt vmcnt(0)" ::: "memory");
        } else {
            XB_SPIN(xb_ld(&bar[XB_XGEN(xx)]) == gen, bar);
            __builtin_amdgcn_fence(__ATOMIC_ACQUIRE, "agent");
            asm volatile("s_waitcnt vmcnt(0)" ::: "memory");
        }
    }
    __syncthreads();
}

#define MFMA32(a, b, c) __builtin_amdgcn_mfma_f32_32x32x16_bf16((a), (b), (c), 0, 0, 0)
__device__ __forceinline__ s16x4 tr_read(LAS unsigned char* p) { return __builtin_amdgcn_ds_read_tr16_b64_v4i16((LAS s16x4*)p); }
__device__ __forceinline__ float fast_exp2(float x) { return __builtin_amdgcn_exp2f(x); }
__device__ __forceinline__ float sigmoid_f(float x) { return __builtin_amdgcn_rcpf(1.f + __expf(-x)); }
constexpr int KP128 = 272, KP192 = 400, VP = 320;
struct AttnArgs {
    const bf16_t* Q; int ldq, qhs;
    const bf16_t* K; int ldk, khs;
    const bf16_t* K2; int ldk2;
    const bf16_t* V; int ldv, vhs;
    bf16_t* O; int ldo, ocol0;
    float sc2;
    const float* cum2_;
    const unsigned* sel_;
    const bf16_t* P;
    const bf16_t* ocmp_; const bf16_t* owin_;
};
template <int MODE, int DK, int HG>
__device__ __forceinline__ void attn_unit(LAS unsigned char* lds, const AttnArgs& A, int b, int kvh, int qb) {
    constexpr int KPB = (DK == 128) ? KP128 : KP192, NKK = DK / 16, QT = 256 / HG;
    constexpr int KS_OFF = 0, VS_OFF = 64 * KPB, CK_OFF = VS_OFF + 64 * VP, STG = CK_OFF + 256, UM_OFF = 2 * STG;
    int tid_op = threadIdx.x; asm volatile("" : "+v"(tid_op));
    const int tid = tid_op, w = __builtin_amdgcn_readfirstlane(tid >> 6), lane = tid & 63, r = lane & 31, hh = lane >> 5;
    const int hd = (HG == 4) ? kvh * 4 + (w & 3) : kvh;
    const int t0 = qb * QT, tw0 = t0 + 32 * (w / HG), t = tw0 + r; const size_t mrow = (size_t)b * T + t; const size_t brow = (size_t)b * T;
    LAS unsigned* ums = (LAS unsigned*)(lds + UM_OFF);
    bf16x8 qf[NKK];
    { const bf16_t* qp = A.Q + mrow * A.ldq + (size_t)hd * A.qhs + 8 * hh;
#pragma unroll
      for (int kk = 0; kk < NKK; ++kk) qf[kk] = *(const bf16x8*)(qp + 16 * kk); }
    float cq = 0.f; unsigned selw = 0xffffffffu; unsigned um = 0xffffffffu;
    if (MODE == 1) cq = A.cum2_[mrow * 8 + hd];
    if (MODE == 3) {
        selw = A.sel_[mrow * 2 + kvh];
        __syncthreads();
        if (w == 0) { unsigned v = A.sel_[(brow + t0 + lane) * 2 + kvh];
#pragma unroll
            for (int o = 1; o < 64; o <<= 1) v |= __shfl_xor(v, o);
            if (lane == 0) ums[0] = v; }
        __syncthreads(); um = ums[0];
    }
    int j0, j1;
    if (MODE == 2) { j0 = t0 / 64 - 8; if (j0 < 0) j0 = 0; j1 = t0 / 64 + 1; } else { j0 = 0; j1 = (t0 + QT) / 64; }
    f32x16 Oa[4];
#pragma unroll
    for (int i = 0; i < 4; ++i)
#pragma unroll
        for (int e = 0; e < 16; ++e) Oa[i][e] = 0.f;
    float mrun = -1e30f, lrun = 0.f;
    u32x4 kreg[3], vreg[2]; float ckreg = 0.f;
#define AT_LOADK(jj) do { const size_t kvrow = brow + (size_t)(jj) * 64; \
        _Pragma("unroll") for (int i = 0; i < 2; ++i) { const int c = tid + 512 * i, row = c >> 4, cc = c & 15; \
            kreg[i] = *(const u32x4*)(A.K + (kvrow + row) * A.ldk + (size_t)kvh * A.khs + 8 * cc); } \
        if (DK == 192) { const int row = tid >> 3, cc = tid & 7; kreg[2] = *(const u32x4*)(A.K2 + (kvrow + row) * A.ldk2 + 8 * cc); } } while (0)
#define AT_LOADV(jj) do { const size_t kvrow = brow + (size_t)(jj) * 64; \
        _Pragma("unroll") for (int i = 0; i < 2; ++i) { const int c = tid + 512 * i, row = c >> 4, cc = c & 15; \
            vreg[i] = *(const u32x4*)(A.V + (kvrow + row) * A.ldv + (size_t)kvh * A.vhs + 8 * cc); } \
        if (MODE == 1) { if (tid < 64) ckreg = A.cum2_[(kvrow + tid) * 8 + hd]; } } while (0)
#define AT_STOREK(sb) do { LAS unsigned char* Ks_ = lds + (sb) * STG + KS_OFF; \
        _Pragma("unroll") for (int i = 0; i < 2; ++i) { const int c = tid + 512 * i, row = c >> 4, cc = c & 15; *(LAS u32x4*)(Ks_ + row * KPB + 16 * cc) = kreg[i]; } \
        if (DK == 192) { const int row = tid >> 3, cc = tid & 7; *(LAS u32x4*)(Ks_ + row * KPB + 256 + 16 * cc) = kreg[2]; } } while (0)
#define AT_STOREV(sb) do { LAS unsigned char* Vs_ = lds + (sb) * STG + VS_OFF; LAS float* cks_ = (LAS float*)(lds + (sb) * STG + CK_OFF); \
        _Pragma("unroll") for (int i = 0; i < 2; ++i) { const int c = tid + 512 * i, row = c >> 4, cc = c & 15; *(LAS u32x4*)(Vs_ + row * VP + 16 * cc) = vreg[i]; } \
        if (MODE == 1) { if (tid < 64) cks_[tid] = ckreg; } } while (0)
#define AT_NEXT(jj, res) do { int q_ = (jj) + 1; if (MODE == 3) { while (q_ < j1 && !((um >> q_) & 1u)) ++q_; } res = q_; } while (0)
#define AT_ACTIVE(jj) (((jj) * 64 <= tw0 + 31) && (MODE != 2 || (jj) * 64 + 63 > tw0 - 512))
    constexpr int FB = (DK == 192) ? 3 : 4, NFB = 2 * NKK / FB;
#define AT_LDF(dst, bi) do { _Pragma("unroll") for (int q_ = 0; q_ < FB; ++q_) { const int f_ = FB * (bi) + q_, kb_ = f_ / NKK, kk_ = f_ % NKK; \
            dst[q_] = *(const LAS bf16x8*)(Ks_ + (32 * kb_ + r) * KPB + (16 * kk_ + 8 * hh) * 2); } } while (0)
#define AT_MMF(src, bi) do { _Pragma("unroll") for (int q_ = 0; q_ < FB; ++q_) { const int f_ = FB * (bi) + q_, kb_ = f_ / NKK, kk_ = f_ % NKK; \
            if (kk_ == 0) S[kb_] = MFMA32(src[q_], qf[kk_], fz_); else S[kb_] = MFMA32(src[q_], qf[kk_], S[kb_]); } } while (0)
#define AT_QK(jj, sb) do { if (AT_ACTIVE(jj)) { LAS unsigned char* Ks_ = lds + (sb) * STG + KS_OFF; \
        f32x16 fz_; _Pragma("unroll") for (int e = 0; e < 16; ++e) fz_[e] = 0.f;     \
        bf16x8 fa_[FB], fb_[FB]; \
        AT_LDF(fa_, 0); __builtin_amdgcn_sched_barrier(0); \
        _Pragma("unroll") for (int bi = 0; bi < NFB; ++bi) { \
            if (bi & 1) { if (bi + 1 < NFB) AT_LDF(fa_, bi + 1); __builtin_amdgcn_sched_barrier(0); AT_MMF(fb_, bi); __builtin_amdgcn_sched_barrier(0); } \
            else        { if (bi + 1 < NFB) AT_LDF(fb_, bi + 1); __builtin_amdgcn_sched_barrier(0); AT_MMF(fa_, bi); __builtin_amdgcn_sched_barrier(0); } } } } while (0)
    const int trq = (lane & 15) >> 2, trp = lane & 3, trb = (lane >> 4) & 1;
    const bool grpB = w >= 4;
    f32x16 S[2]; bf16x8 pf[2][2];
    int jc = j0, jn1, jn2;
    AT_NEXT(jc, jn1); if (jn1 < j1) { AT_NEXT(jn1, jn2); } else jn2 = j1;
    __syncthreads();
    AT_LOADK(jc); AT_LOADV(jc); AT_STOREK(0); AT_STOREV(0);
    if (jn1 < j1) { AT_LOADK(jn1); AT_STOREK(1); }
    if (jn2 < j1) AT_LOADK(jn2);
    if (jn1 < j1) AT_LOADV(jn1);
    __syncthreads();
    AT_QK(jc, 0);
    if (grpB) __syncthreads();
    int n = 0;
    for (;;) {
        const int kv0 = jc * 64;
        const bool active = AT_ACTIVE(jc);
        bool anychg = false; float alpha = 1.f;
        if (active) {
            LAS float* cks = (LAS float*)(lds + (n & 1) * STG + CK_OFF); (void)cks;
            const bool need_mask = (kv0 + 63 > tw0) || (MODE == 2 && kv0 <= tw0 + 31 - 512);
            const bool selok = (MODE != 3) || ((selw >> jc) & 1u);
            float mloc = -1e30f; float muse; float psum = 0.f;
            if (MODE == 1) {
            if (need_mask) {
#pragma unroll
            for (int kb = 0; kb < 2; ++kb)
#pragma unroll
                for (int g4 = 0; g4 < 4; ++g4) {
                    const f32x4 ck4 = *(const LAS f32x4*)(cks + 32 * kb + 8 * g4 + 4 * hh);
#pragma unroll
                    for (int e = 0; e < 4; ++e) { const int key = kv0 + 32 * kb + 8 * g4 + 4 * hh + e;
                        float s2 = S[kb][4 * g4 + e] * A.sc2 + (cq - ck4[e]);
                        s2 = (key <= t) ? s2 : -1e30f; S[kb][4 * g4 + e] = s2; mloc = fmaxf(mloc, s2); }
                }
            } else {
#pragma unroll
            for (int kb = 0; kb < 2; ++kb)
#pragma unroll
                for (int g4 = 0; g4 < 4; ++g4) {
                    const f32x4 ck4 = *(const LAS f32x4*)(cks + 32 * kb + 8 * g4 + 4 * hh);
#pragma unroll
                    for (int e = 0; e < 4; ++e) { const float s2 = S[kb][4 * g4 + e] * A.sc2 + (cq - ck4[e]); S[kb][4 * g4 + e] = s2; mloc = fmaxf(mloc, s2); }
                }
            }
            mloc = fmaxf(mloc, __shfl_xor(mloc, 32));
            const float mnew = fmaxf(mrun, mloc); muse = (mnew < -1e29f) ? 0.f : mnew;
            alpha = fast_exp2(mrun - muse); anychg = __builtin_amdgcn_ballot_w64(mnew > mrun) != 0ull; mrun = mnew;
#pragma unroll
            for (int kb = 0; kb < 2; ++kb)
#pragma unroll
                for (int e = 0; e < 16; ++e) { const float p = fast_exp2(S[kb][e] - muse); S[kb][e] = p; psum += p; }
            } else {
            if (need_mask) {
#pragma unroll
            for (int kb = 0; kb < 2; ++kb)
#pragma unroll
                for (int e = 0; e < 16; ++e) { const int key = kv0 + 32 * kb + (e & 3) + 8 * (e >> 2) + 4 * hh;
                    bool valid = selok && (key <= t); if (MODE == 2) valid = valid && (key > t - 512);
                    const float sr = valid ? S[kb][e] : -3e38f; S[kb][e] = sr; mloc = fmaxf(mloc, sr); }
            } else {
#pragma unroll
            for (int kb = 0; kb < 2; ++kb)
#pragma unroll
                for (int e = 0; e < 16; ++e) { float sr = S[kb][e]; if (MODE == 3) { sr = selok ? sr : -3e38f; S[kb][e] = sr; } mloc = fmaxf(mloc, sr); }
            }
            mloc = fmaxf(mloc, __shfl_xor(mloc, 32)) * A.sc2;
            const float mnew = fmaxf(mrun, mloc); muse = (mnew < -1e29f) ? 0.f : mnew;
            alpha = fast_exp2(mrun - muse); anychg = __builtin_amdgcn_ballot_w64(mnew > mrun) != 0ull; mrun = mnew;
            const float negm = -muse, scv = A.sc2;
#pragma unroll
            for (int kb = 0; kb < 2; ++kb)
#pragma unroll
                for (int e = 0; e < 16; ++e) { float y; asm("v_fma_f32 %0, %1, %2, %3" : "=v"(y) : "v"(S[kb][e]), "s"(scv), "v"(negm)); const float p = fast_exp2(y); S[kb][e] = p; psum += p; }
            }
            lrun = lrun * alpha + psum;
#pragma unroll
            for (int kb = 0; kb < 2; ++kb)
#pragma unroll
                for (int s = 0; s < 2; ++s) { u32x4 pw; pw.x = pk_bf16(S[kb][8 * s], S[kb][8 * s + 1]); pw.y = pk_bf16(S[kb][8 * s + 2], S[kb][8 * s + 3]); pw.z = pk_bf16(S[kb][8 * s + 4], S[kb][8 * s + 5]); pw.w = pk_bf16(S[kb][8 * s + 6], S[kb][8 * s + 7]);
                    pf[kb][s] = __builtin_bit_cast(bf16x8, pw); }
            if (anychg) {
#pragma unroll
            for (int i = 0; i < 4; ++i)
#pragma unroll
                for (int e = 0; e < 16; ++e) Oa[i][e] *= alpha;
            }
        }
        __syncthreads();
        const bool has1 = jn1 < j1;
        if (jn2 < j1) AT_STOREK(n & 1);
        if (has1) AT_STOREV((n + 1) & 1);
        int jn3 = j1; if (jn2 < j1) { AT_NEXT(jn2, jn3); }
        if (jn3 < j1) AT_LOADK(jn3);
        if (jn2 < j1) AT_LOADV(jn2);
        __builtin_amdgcn_s_setprio(1);
        if (active) {
            LAS unsigned char* Vs = lds + (n & 1) * STG + VS_OFF;
            LAS unsigned char* vbase = Vs + (4 * hh + trq) * VP + (16 * trb + 4 * trp) * 2;
            bf16x8 va[4], vb[4];
#define AT_LDV(dst, dvb_) do { _Pragma("unroll") for (int q_ = 0; q_ < 4; ++q_) { LAS unsigned char* vp_ = vbase + (32 * (q_ >> 1) + 16 * (q_ & 1)) * VP + (32 * (dvb_)) * 2; \
                const s16x4 lo_ = tr_read(vp_), hi_ = tr_read(vp_ + 8 * VP); dst[q_] = __builtin_shufflevector(lo_, hi_, 0, 1, 2, 3, 4, 5, 6, 7); } } while (0)
#define AT_MMV(src, dvb_) do { _Pragma("unroll") for (int q_ = 0; q_ < 4; ++q_) Oa[dvb_] = MFMA32(src[q_], pf[q_ >> 1][q_ & 1], Oa[dvb_]); } while (0)
#define SB_ __builtin_amdgcn_sched_barrier(0)
            SB_; AT_LDV(va, 0); SB_; AT_LDV(vb, 1); SB_; AT_MMV(va, 0); SB_; AT_LDV(va, 2); SB_; AT_MMV(vb, 1); SB_; AT_LDV(vb, 3); SB_; AT_MMV(va, 2); SB_; AT_MMV(vb, 3); SB_;
#undef SB_
#undef AT_LDV
#undef AT_MMV
        }
        if (has1) AT_QK(jn1, (n + 1) & 1);
        __builtin_amdgcn_s_setprio(0);
        __syncthreads();
        if (!has1) break;
        jc = jn1; jn1 = jn2; jn2 = jn3; ++n;
    }
    if (!grpB) __syncthreads();
    const float ltot = lrun + __shfl_xor(lrun, 32);
    float inv = ltot > 0.f ? 1.f / ltot : 0.f;
    if (MODE == 2) inv *= sigmoid_f(bf2f(A.P[mrow * HYBN + 5632 + hd * 3 + 2]));
    if (MODE == 3) inv *= sigmoid_f(bf2f(A.P[mrow * HYBN + 5632 + hd * 3 + 1]));
    bf16_t* op = A.O + mrow * A.ldo + A.ocol0 + hd * 128 + 4 * hh;
#pragma unroll
    for (int dvb = 0; dvb < 4; ++dvb)
#pragma unroll
        for (int g4 = 0; g4 < 4; ++g4) {
            float v0 = Oa[dvb][4 * g4] * inv, v1 = Oa[dvb][4 * g4 + 1] * inv, v2 = Oa[dvb][4 * g4 + 2] * inv, v3 = Oa[dvb][4 * g4 + 3] * inv;
            if (MODE == 3) { const size_t o = mrow * 1024 + hd * 128 + 32 * dvb + 8 * g4 + 4 * hh; const u32x2 a = *(const u32x2*)(A.ocmp_ + o), c = *(const u32x2*)(A.owin_ + o);
                v0 += bf_lo(a.x) + bf_lo(c.x); v1 += bf_hi(a.x) + bf_hi(c.x); v2 += bf_lo(a.y) + bf_lo(c.y); v3 += bf_hi(a.y) + bf_hi(c.y); }
            u32x2 o2; o2.x = pk_bf16(v0, v1); o2.y = pk_bf16(v2, v3); *(u32x2*)(op + 32 * dvb + 8 * g4) = o2; }
}
#undef AT_LOADK
#undef AT_LOADV
#undef AT_STOREK
#undef AT_STOREV
#undef AT_NEXT
#undef AT_ACTIVE
#undef AT_QK
#undef AT_LDF
#undef AT_MMF
__device__ __forceinline__ void cmp_unit(LAS unsigned char* lds, const bf16_t* P, const bf16_t* KC, const bf16_t* VC, bf16_t* OCMP, unsigned* SEL, int b, int g, int qb) {
    constexpr int VS_OFF = 128 * KP128, IMP_OFF = VS_OFF + 128 * VP;
    int tid_op = threadIdx.x; asm volatile("" : "+v"(tid_op));
    const int tid = tid_op, w = __builtin_amdgcn_readfirstlane(tid >> 6), lane = tid & 63, r = lane & 31, hh = lane >> 5;
    const int hd = g * 4 + (w & 3), t0 = qb * 64, t = t0 + 32 * (w >> 2) + r; const size_t mrow = (size_t)b * T + t;
    LAS unsigned char* Ks = lds; LAS unsigned char* Vs = lds + VS_OFF; LAS float* IMPW = (LAS float*)(lds + IMP_OFF);
    __syncthreads();
    { const bf16_t* kc = KC + (size_t)(b * 2 + g) * 128 * 128; const bf16_t* vc = VC + (size_t)(b * 2 + g) * 128 * 128;
#pragma unroll
      for (int i = 0; i < 4; ++i) { const int c = tid + 512 * i, row = c >> 4, cc = c & 15;
          *(LAS u32x4*)(Ks + row * KP128 + 16 * cc) = *(const u32x4*)(kc + row * 128 + 8 * cc);
          *(LAS u32x4*)(Vs + row * VP + 16 * cc) = *(const u32x4*)(vc + row * 128 + 8 * cc); } }
    bf16x8 qf[8];
    { const bf16_t* qp = P + mrow * HYBN + hd * 128 + 8 * hh;
#pragma unroll
      for (int kk = 0; kk < 8; ++kk) qf[kk] = *(const bf16x8*)(qp + 16 * kk); }
    __syncthreads();
    f32x16 S[4];
#pragma unroll
    for (int kb = 0; kb < 4; ++kb) {
#pragma unroll
        for (int e = 0; e < 16; ++e) S[kb][e] = 0.f;
#pragma unroll
        for (int kk = 0; kk < 8; ++kk) { const bf16x8 kf = *(const LAS bf16x8*)(Ks + (32 * kb + r) * KP128 + (16 * kk + 8 * hh) * 2); S[kb] = MFMA32(kf, qf[kk], S[kb]); }
    }
    const float sc2 = 0.08838834764831845f * LOG2E;
    float mloc = -1e30f;
#pragma unroll
    for (int kb = 0; kb < 4; ++kb)
#pragma unroll
        for (int e = 0; e < 16; ++e) { const int n = 32 * kb + (e & 3) + 8 * (e >> 2) + 4 * hh; const bool valid = (n < 127) && (16 * n + 31 <= t);
            const float s2 = valid ? S[kb][e] * sc2 : -1e30f; S[kb][e] = s2; mloc = fmaxf(mloc, s2); }
    mloc = fmaxf(mloc, __shfl_xor(mloc, 32));
    const float muse = (mloc < -1e29f) ? 0.f : mloc;
    float psum = 0.f;
#pragma unroll
    for (int kb = 0; kb < 4; ++kb)
#pragma unroll
        for (int e = 0; e < 16; ++e) { const float p = fast_exp2(S[kb][e] - muse); S[kb][e] = p; psum += p; }
    const float ltot = psum + __shfl_xor(psum, 32);
    const float inv = ltot > 0.f ? 1.f / ltot : 0.f;
    {
        float prevrecv = 0.f;
#pragma unroll
        for (int kb = 0; kb < 4; ++kb)
#pragma unroll
            for (int g4 = 0; g4 < 4; ++g4) { const int Gi = 4 * kb + g4;
                const float p0 = S[kb][4 * g4], p1 = S[kb][4 * g4 + 1], p2 = S[kb][4 * g4 + 2], p3 = S[kb][4 * g4 + 3];
                const float ai = ((p0 + p1) + p2 + 0.5f * p3) * inv, bi = 0.5f * p3 * inv;
                const float recv = __shfl_xor(bi, 32);
                const float tot = ai + (hh ? recv : prevrecv); prevrecv = recv;
                IMPW[(w * 32 + r) * 33 + 2 * Gi + hh] = tot; }
    }
    f32x16 Oa[4];
#pragma unroll
    for (int i = 0; i < 4; ++i)
#pragma unroll
        for (int e = 0; e < 16; ++e) Oa[i][e] = 0.f;
    const int trq = (lane & 15) >> 2, trp = lane & 3, trb = (lane >> 4) & 1;
#pragma unroll
    for (int kb = 0; kb < 4; ++kb)
#pragma unroll
        for (int s = 0; s < 2; ++s) { u32x4 pw; pw.x = pk_bf16(S[kb][8 * s], S[kb][8 * s + 1]); pw.y = pk_bf16(S[kb][8 * s + 2], S[kb][8 * s + 3]); pw.z = pk_bf16(S[kb][8 * s + 4], S[kb][8 * s + 5]); pw.w = pk_bf16(S[kb][8 * s + 6], S[kb][8 * s + 7]);
            const bf16x8 pf = __builtin_bit_cast(bf16x8, pw);
#pragma unroll
            for (int dvb = 0; dvb < 4; ++dvb) { LAS unsigned char* vp = Vs + (32 * kb + 16 * s + 4 * hh + trq) * VP + (32 * dvb + 16 * trb + 4 * trp) * 2;
                const s16x4 lo = tr_read(vp), hi = tr_read(vp + 8 * VP);
                const bf16x8 vf = __builtin_shufflevector(lo, hi, 0, 1, 2, 3, 4, 5, 6, 7);
                Oa[dvb] = MFMA32(vf, pf, Oa[dvb]); } }
    const float og = inv * sigmoid_f(bf2f(P[mrow * HYBN + 5632 + hd * 3 + 0]));
    bf16_t* op = OCMP + mrow * 1024 + hd * 128 + 4 * hh;
#pragma unroll
    for (int dvb = 0; dvb < 4; ++dvb)
#pragma unroll
        for (int g4 = 0; g4 < 4; ++g4) { u32x2 o2; o2.x = pk_bf16(Oa[dvb][4 * g4] * og, Oa[dvb][4 * g4 + 1] * og); o2.y = pk_bf16(Oa[dvb][4 * g4 + 2] * og, Oa[dvb][4 * g4 + 3] * og); *(u32x2*)(op + 32 * dvb + 8 * g4) = o2; }
    __syncthreads();
    {
        const int cur = qb, jj = lane & 31, hsel = lane >> 5;
#pragma unroll 1
        for (int it = 0; it < 4; ++it) {
            const int tq = 2 * (w * 4 + it) + hsel, sub = tq >> 5, rr = tq & 31;
            const LAS float* ip = IMPW + ((4 * sub) * 32 + rr) * 33 + jj;
            const float imp = ((ip[0] + ip[32 * 33]) + ip[2 * 32 * 33]) + ip[3 * 32 * 33];
            const bool cand = (jj >= 1) && (jj <= cur - 2);
            const float val = cand ? imp : -1.f;
            int rank = 0;
#pragma unroll
            for (int k = 1; k < 30; ++k) { const float vk = __shfl(val, (lane & 32) | k); rank += ((vk > val) || (vk == val && k < jj)) ? 1 : 0; }
            const bool selb = cand && (rank < 5);
            const unsigned long long bal = __builtin_amdgcn_ballot_w64(selb);
            unsigned mask = (unsigned)(bal >> (32 * hsel));
            if (cur <= 7) mask = (2u << cur) - 1u; else mask |= 1u | (1u << cur) | (1u << (cur - 1));
            if (jj == 0) SEL[((size_t)b * T + t0 + tq) * 2 + g] = mask;
        }
    }
}
__device__ __forceinline__ int fetch_unit_x(unsigned* ctr8, int xcd, int per, LAS int* slot) {
    __syncthreads();
    if (threadIdx.x == 0) { int res = -1;
        for (int k = 0; k < 8; ++k) { const int x = (xcd + k) & 7; if (__hip_atomic_load(ctr8 + 64 * x, __ATOMIC_RELAXED, __HIP_MEMORY_SCOPE_AGENT) >= (unsigned)per) continue;
            const unsigned v = atomicAdd(ctr8 + 64 * x, 1u); if (v < (unsigned)per) { res = x * per + (int)v; break; } }
        *slot = res; }
    __syncthreads();
    return *slot;
}
__global__ void __launch_bounds__(512, 2) mega_fwd(Args a) {
    extern __shared__ __attribute__((aligned(16))) unsigned char lds_raw[];
    LAS unsigned char* lds = (LAS unsigned char*)lds_raw;
    LAS int* slot = (LAS int*)(lds + MISC_OFF);
    cg::grid_group grid = cg::this_grid();
    const int tid = threadIdx.x, lane = tid & 63, wave = tid >> 6, G = gridDim.x, bid = blockIdx.x;
    const int gw = bid * 8 + wave, NGW = G * 8, gtid = bid * 512 + tid, NGT = G * 512;
    unsigned char* ws = a.ws;
    unsigned* ctl = (unsigned*)(ws + WS_CTL);
#define SSQ ((float*)(a.ws + WS_SSQ))
#define SSQ2 ((float*)(a.ws + WS_SSQ2))
#define CUM2 ((float*)(a.ws + WS_CUM))
#define SEL ((unsigned*)(a.ws + WS_SEL))
#define BPART ((float*)(a.ws + WS_BPART))
#define BIASPE ((float*)(a.ws + WS_BIASPE))
#define ROPE128 ((float*)(a.ws + WS_ROPE128))
#define ROPE64 ((float*)(a.ws + WS_ROPE64))
#define HID ((bf16_t*)(a.ws + WS_HID))
#define KCVC ((bf16_t*)(a.ws + WS_KCVC))
#define HYBIN ((bf16_t*)(a.ws + WS_HYBIN))
#define HYBOUT ((bf16_t*)(a.ws + WS_HYBOUT))
#define MLAIN ((bf16_t*)(a.ws + WS_MLAIN))
#define UQKV ((bf16_t*)(a.ws + WS_UQKV))
#define MLAOUT ((bf16_t*)(a.ws + WS_MLAOUT))
#define CMPW1 ((bf16_t*)(a.ws + WS_CMPW1))
#define XB ((bf16_t*)(a.ws + WS_XB))
#define ACT ((bf16_t*)(a.ws + WS_ACT))
#define OBUF ((bf16_t*)(a.ws + WS_OBUF))
#define PBUF ((bf16_t*)(a.ws + WS_PBUF))
#define QR ((bf16_t*)(a.ws + WS_QR))
#define CMPIN ((bf16_t*)(a.ws + WS_CMPIN))
#define OWIN ((bf16_t*)(a.ws + WS_OWIN))
#define OCMP ((bf16_t*)(a.ws + WS_OCMP))
#define CB ((bf16_t*)(a.ws + WS_C))
#define QBUF ((bf16_t*)(a.ws + WS_QBUF))
#define KVBUF ((bf16_t*)(a.ws + WS_KVBUF))
    float* X = a.out;

    if (PROBE_TSMASK) { if (blockIdx.x == 0 && threadIdx.x == 0) ((unsigned long long*)(a.ws + 65536))[23] = __builtin_amdgcn_s_memrealtime(); }
    if (tid < 2) ((volatile LAS unsigned*)(lds + MISC_OFF + 32))[tid] = 0u;
    if (a.ws == nullptr) grid.sync();
    __syncthreads();
    XcdBarrier xbar = xcd_barrier_post(ctl + 4096, (volatile LAS unsigned*)(lds + MISC_OFF + 32));
    int ts_idx = 0; (void)ts_idx;
    if (PROBE_TSMASK) { if (bid == 0 && tid == 0) ((unsigned long long*)(a.ws + 65536))[0] = __builtin_amdgcn_s_memrealtime(); }
#pragma unroll 1
    for (int rep = 0; rep < 1 + PROBE_P0X2; ++rep) {
    {
        LAS float* scr = (LAS float*)(lds + wave * 16384);
#define TJOBX(MODE, W, K, N, NP, gain, dst, gw_, ngw_) for (int it = (gw_); it < ((K) / 64) * ((NP) / 32); it += (ngw_)) transpose_item<MODE>(W, K, N, NP, gain, dst, scr, it, lane)
#define TJOBQ(MODE, W, K, N, NP, gain, dst, ctr, it0, it1) do { int tid_q = threadIdx.x; asm volatile("" : "+v"(tid_q)); const int lane = tid_q & 63, wave = __builtin_amdgcn_readfirstlane(tid_q >> 6); \
        LAS float* scr = (LAS float*)(lds + wave * 16384); \
        for (;;) { __syncthreads(); if (tid_q == 0) *slot = (it0) + (int)atomicAdd((ctr), 8u); __syncthreads(); const int base_ = *slot; if (base_ >= (it1)) break; \
            if (base_ + wave < (it1)) transpose_item<MODE>(W, K, N, NP, gain, dst, scr, base_ + wave, lane); } } while (0)
#define TJOBR(MODE, W, K, N, NP, gain, dst, gw_, ngw_, it0, it1) for (int it = (it0) + (gw_); it < (it1); it += (ngw_)) transpose_item<MODE>(W, K, N, NP, gain, dst, scr, it, lane)
        TJOBX(1, a.in[2], 2048, 11264, 11264, a.in[1], (bf16_t*)(ws + WS_W1T), gw, NGW);
        TJOBX(0, a.in[3], 5632, 2048, 2048, (const float*)nullptr, (bf16_t*)(ws + WS_W2T), gw, NGW);
        TJOBR(1, a.in[6] + (size_t)2048 * 11264, 2048, 11264, 11264, a.in[5] + 2048, (bf16_t*)(ws + WS_W1T + (size_t)3 * 44 * MiB), gw, NGW, 9088, 11264);
    }
    for (int m = gw; m < M; m += NGW) {
        const f32x4* xr = (const f32x4*)(a.in[0] + (size_t)m * D) + lane; u32x2* xo = (u32x2*)(XB + (size_t)m * D) + lane; float s = 0.f;
#pragma unroll
        for (int j = 0; j < 8; ++j) { const f32x4 v = xr[64 * j]; s += (v[0] * v[0] + v[1] * v[1]) + (v[2] * v[2] + v[3] * v[3]); u32x2 o; o.x = pk_bf16(v[0], v[1]); o.y = pk_bf16(v[2], v[3]); xo[64 * j] = o; }
        s = wave_sum(s);
        if (lane < 32) SSQ[(size_t)m * 32 + lane] = lane == 0 ? s : 0.f;
    }
    for (int i = gtid; i < 2048 * 64; i += NGT) { const int t = i >> 6, ii = i & 63; const float e = (float)(2 * ii) / 128.f; const float pw = (float)pow(10000.0, (double)e); const float inv = 1.0f / pw; const float ang = (float)t * inv;
        ROPE128[2 * i] = cosf(ang); ROPE128[2 * i + 1] = sinf(ang); }
    for (int i = gtid; i < 2048 * 32; i += NGT) { const int t = i >> 5, ii = i & 31; const float e = (float)(2 * ii) / 64.f; const float pw = (float)pow(10000.0, (double)e); const float inv = 1.0f / pw; const float ang = (float)t * inv;
        ROPE64[2 * i] = cosf(ang); ROPE64[2 * i + 1] = sinf(ang); }
    if (bid < 64) { const int kv = tid >> 8, c = tid & 255; const float* pe = a.in[10] + kv * 4096 + bid * 64; const float* w1 = a.in[11] + (size_t)kv * 4096 * 256 + (size_t)bid * 64 * 256 + c; float s = 0.f;
#pragma unroll 8
        for (int k = 0; k < 64; ++k) s += pe[k] * w1[(size_t)k * 256];
        BPART[bid * 512 + tid] = s; }
    }
    GSYNC();

#pragma unroll 1
    for (int k = 0; k < 4; ++k) {
#pragma unroll 1
        for (int rep = 0; rep < 1 + PROBE_UPX2; ++rep) {
            pg8::Gemm g{XB, XB, (const bf16_t*)(ws + WS_W1T + (size_t)k * 44 * MiB), M, 11264, 2048, 2048, 1 << 30};
            pg8::StaticOrder S; S.init(M, 11264, G, bid);
            pg8::EpiSwiglu E{ACT, DFF, SSQ};
            pg8::gemm_phase<pg8::EpiSwiglu, pg8::StaticOrder, true, true>(lds, g, S, E);
        }
        if (bid >= G / 2) {
            int tid_o = threadIdx.x; asm volatile("" : "+v"(tid_o)); const int lane = tid_o & 63, wave = __builtin_amdgcn_readfirstlane(tid_o >> 6);
            LAS float* scr = (LAS float*)(lds + wave * 16384);
            const int tgw = (bid - G / 2) * 8 + wave, TNG = (G - G / 2) * 8;
            if (k == 0) {
                TJOBX(2, a.in[8], 2048, 5664, 5888, a.in[4], HYBIN, tgw, TNG);
                TJOBX(0, a.in[9], 2048, 2048, 2048, (const float*)nullptr, HYBOUT, tgw, TNG);
                TJOBX(0, a.in[11], 4096, 256, 256, (const float*)nullptr, CMPW1, tgw, TNG);
                TJOBX(0, a.in[11] + (size_t)4096 * 256, 4096, 256, 256, (const float*)nullptr, CMPW1 + (size_t)256 * 4096, tgw, TNG);
                TJOBR(1, a.in[6], 2048, 11264, 11264, a.in[5], (bf16_t*)(ws + WS_W1T + (size_t)1 * 44 * MiB), tgw, TNG, 0, 3680);
            } else if (k == 1) {
                TJOBX(0, a.in[7], 5632, 2048, 2048, (const float*)nullptr, (bf16_t*)(ws + WS_W2T + (size_t)1 * 22 * MiB), tgw, TNG);
                TJOBR(1, a.in[2] + (size_t)2048 * 11264, 2048, 11264, 11264, a.in[1] + 2048, (bf16_t*)(ws + WS_W1T + (size_t)2 * 44 * MiB), tgw, TNG, 0, 6656);
            } else if (k == 2) {
                TJOBX(0, a.in[3] + (size_t)5632 * 2048, 5632, 2048, 2048, (const float*)nullptr, (bf16_t*)(ws + WS_W2T + (size_t)2 * 22 * MiB), tgw, TNG);
                TJOBX(4, a.in[14], 2048, 1088, 1280, a.in[4] + 2048, MLAIN, tgw, TNG);
                TJOBX(3, a.in[17], 512, 3072, 3072, a.in[15], UQKV, tgw, TNG);
                TJOBX(0, a.in[18], 512, 4096, 4096, a.in[16], UQKV + (size_t)3072 * 512, tgw, TNG);
                TJOBX(0, a.in[19], 2048, 2048, 2048, (const float*)nullptr, MLAOUT, tgw, TNG);
                TJOBR(1, a.in[6] + (size_t)2048 * 11264, 2048, 11264, 11264, a.in[5] + 2048, (bf16_t*)(ws + WS_W1T + (size_t)3 * 44 * MiB), tgw, TNG, 0, 1728);
            } else {
                TJOBX(0, a.in[7] + (size_t)5632 * 2048, 5632, 2048, 2048, (const float*)nullptr, (bf16_t*)(ws + WS_W2T + (size_t)3 * 22 * MiB), tgw, TNG);
            }
        }
        GSYNC();
        {
            pg8::Gemm g{ACT, ACT, (const bf16_t*)(ws + WS_W2T + (size_t)k * 22 * MiB), M, 2048, DFF, DFF, 1 << 30};
            pg8::StaticOrder S; S.init(M, 2048, G, bid);
            pg8::EpiResid E{k == 0 ? a.in[0] : X, X, XB, SSQ, 0.5f};
            pg8::gemm_phase<pg8::EpiResid, pg8::StaticOrder, true, true>(lds, g, S, E);
        }
        GSYNC();
        if (k == 0) {
            {
                pg8::Gemm g{XB, XB, HYBIN, M, HYBN, 2048, 2048, 1 << 30};
                pg8::StaticOrder S; S.init(M, HYBN, G, bid);
                pg8::EpiScale<8, false> E{PBUF, HYBN, PBUF, HYBN, 1 << 30, SSQ, 0, 0, 1.f / 2048.f, nullptr, nullptr};
                pg8::gemm_phase<pg8::EpiScale<8, false>, pg8::StaticOrder, true, true>(lds, g, S, E);
            }
            if (bid >= 224 && G == 256) {
                int tid_o = threadIdx.x; asm volatile("" : "+v"(tid_o)); const int lane = tid_o & 63, wave = __builtin_amdgcn_readfirstlane(tid_o >> 6);
                LAS float* scr = (LAS float*)(lds + wave * 16384);
                TJOBR(1, a.in[6], 2048, 11264, 11264, a.in[5], (bf16_t*)(ws + WS_W1T + (size_t)1 * 44 * MiB), (bid - 224) * 8 + wave, 32 * 8, 3680, 6752);
            } else if (G != 256) {
                int tid_o = threadIdx.x; asm volatile("" : "+v"(tid_o)); const int lane = tid_o & 63, wave = __builtin_amdgcn_readfirstlane(tid_o >> 6);
                LAS float* scr = (LAS float*)(lds + wave * 16384);
                TJOBR(1, a.in[6], 2048, 11264, 11264, a.in[5], (bf16_t*)(ws + WS_W1T + (size_t)1 * 44 * MiB), bid * 8 + wave, G * 8, 3680, 6752);
            }
            GSYNC();
            {
                int tid_o = threadIdx.x; asm volatile("" : "+v"(tid_o)); const int tid = tid_o, lane = tid & 63, wave = __builtin_amdgcn_readfirstlane(tid >> 6), gw = bid * 8 + wave, gtid = bid * 512 + tid; (void)lane; (void)gw; (void)gtid;
                const bool ded = true; const int g2 = gtid - 8192, N2 = NGT - 8192;
                if (gw >= 128) {
                for (int i0 = g2; i0 < M * 12 * 8; i0 += 2 * N2) {
                    u32x4 x1[2], x2[2]; f32x4 cs[2][4]; bf16_t* dstp[2]; bool ok[2];
#pragma unroll
                    for (int e = 0; e < 2; ++e) {
                        const int i = i0 + e * N2; ok[e] = i < M * 12 * 8; const int ii = ok[e] ? i : i0;
                        const int c8 = ii & 7, u = (ii >> 3) % 12, m = ii / 96, t = m & (T - 1);
                        const bf16_t* src; bf16_t* dst;
                        if (u < 8) { src = PBUF + (size_t)m * HYBN + u * 128; dst = QR + (size_t)m * 1024 + u * 128; }
                        else if (u < 10) { src = PBUF + (size_t)m * HYBN + 1536 + (u - 8) * 128; dst = (bf16_t*)src; }
                        else { src = PBUF + (size_t)m * HYBN + 2048 + (u - 10) * 128; dst = (bf16_t*)src; }
                        x1[e] = *(const u32x4*)(src + 8 * c8); x2[e] = *(const u32x4*)(src + 64 + 8 * c8);
                        const f32x4* csp = (const f32x4*)(ROPE128 + ((size_t)t * 64 + 8 * c8) * 2);
#pragma unroll
                        for (int q = 0; q < 4; ++q) cs[e][q] = csp[q];
                        dstp[e] = dst + 8 * c8;
                    }
#pragma unroll
                    for (int e = 0; e < 2; ++e) { u32x4 o1, o2;
#pragma unroll
                        for (int q = 0; q < 4; ++q) { const f32x4 c = cs[e][q]; const float a0 = bf_lo(x1[e][q]), a1 = bf_hi(x1[e][q]), b0 = bf_lo(x2[e][q]), b1 = bf_hi(x2[e][q]);
                            o1[q] = pk_bf16(a0 * c[0] - b0 * c[1], a1 * c[2] - b1 * c[3]); o2[q] = pk_bf16(b0 * c[0] + a0 * c[1], b1 * c[2] + a1 * c[3]); }
                        if (ok[e]) { *(u32x4*)(dstp[e]) = o1; *(u32x4*)(dstp[e] + 64) = o2; } }
                }
                for (int i = g2; i < M * 4 * 16; i += N2) {
                    const int cc = i & 15, gg = (i >> 4) & 1, kv = (i >> 5) & 1, m = i >> 6, b = m >> 11, t = m & (T - 1);
                    *(u32x4*)(CMPIN + ((size_t)kv * 8 + b * 2 + gg) * T * 128 + (size_t)t * 128 + 8 * cc) = *(const u32x4*)(PBUF + (size_t)m * HYBN + 1024 + kv * 256 + gg * 128 + 8 * cc);
                }
                }
                if (gw < 128) {
                    const int seq = bid * 2 + (wave >> 2), wq = wave & 3, b = seq >> 3, h = seq & 7; const float fb = a.in[13][h]; float v[8]; float s = 0.f;
                    const size_t tb = (size_t)b * T + wq * 512 + lane * 8;
#pragma unroll
                    for (int i = 0; i < 8; ++i) { const float z = bf2f(PBUF[(tb + i) * HYBN + 5656 + h]) + fb; const float lf = fminf(z, 0.f) - log1pf(__expf(-fabsf(z))); s += lf; v[i] = s; }
                    float incl = s;
#pragma unroll
                    for (int o = 1; o < 64; o <<= 1) { const float n = __shfl_up(incl, o); if (lane >= o) incl += n; }
                    LAS float* tot = (LAS float*)(lds + MISC_OFF + 64);
                    if (lane == 63) tot[wave] = incl;
                    __syncthreads();
                    float offs = 0.f;
#pragma unroll
                    for (int q = 0; q < 3; ++q) if (q < wq) offs += tot[(wave & 4) + q];
                    const float excl = offs + (incl - s);
#pragma unroll
                    for (int i = 0; i < 8; ++i) CUM2[(tb + i) * 8 + h] = (excl + v[i]) * LOG2E;
                }
                if (gw >= 128 && gw < 128 + 512) { const int o = gw - 128; const float s = wave_sum(BPART[lane * 512 + o]); if (lane == 0) BIASPE[o] = s; }
            }
            GSYNC();
            {
                pg8::Gemm g{CMPIN, CMPIN + (size_t)8 * T * 128, CMPW1, 1024, 512, 4096, 2048, 1};
                pg8::ListOrder S; S.init(1024, 512, G, bid);
                pg8::EpiGelu E{HID, BIASPE};
                pg8::gemm_phase<pg8::EpiGelu, pg8::ListOrder, true, true>(lds, g, S, E);
                AttnArgs af{}; af.Q = PBUF + 2560; af.ldq = HYBN; af.qhs = 128; af.K = PBUF + 3584; af.ldk = HYBN; af.khs = 128; af.K2 = nullptr; af.ldk2 = 0; af.V = PBUF + 4608; af.ldv = HYBN; af.vhs = 128;
                af.O = OBUF; af.ldo = 2048; af.ocol0 = 1024; af.sc2 = 0.08838834764831845f * LOG2E; af.cum2_ = CUM2; af.sel_ = SEL; af.P = PBUF; af.ocmp_ = OCMP; af.owin_ = OWIN;
                AttnArgs aw = af; aw.Q = QR; aw.ldq = 1024; aw.K = PBUF + 2048; aw.V = PBUF + 2304; aw.O = OWIN; aw.ldo = 1024; aw.ocol0 = 0;
                for (int arep = 0; arep < 1 + PROBE_ATTX2; ++arep) for (;;) {
                    const int u = fetch_unit_x(ctl + 64 * 8 * (1 + 4 * arep), (int)xbar.x & 7, 64, slot);
                    if (u < 0) break;
                    const int x = u >> 6, v = u & 63;
                    if (v < 32) { const int qb = 7 - (v >> 2), bh = x + 8 * (v & 3); attn_unit<1, 128, 1>(lds, af, bh >> 3, bh & 7, qb); }
                    else { const int qb = 63 - v, bg = x; attn_unit<2, 128, 4>(lds, aw, bg >> 1, bg & 1, qb); }
                }
                TJOBQ(1, a.in[6], 2048, 11264, 11264, a.in[5], (bf16_t*)(ws + WS_W1T + (size_t)1 * 44 * MiB), ctl + 64 * 40, 6752, 11264);
            }
            GSYNC();
            {
                int tid_o = threadIdx.x; asm volatile("" : "+v"(tid_o)); const int tid = tid_o, lane = tid & 63, wave = __builtin_amdgcn_readfirstlane(tid >> 6), gw = bid * 8 + wave, gtid = bid * 512 + tid; (void)lane; (void)gw; (void)gtid;
                for (int i = gtid; i < 2 * 256 * 128 * 2; i += NGT) {
                    const int ch = i & 1, d = (i >> 1) & 127, rg = (i >> 8) & 255, kv = i >> 16;
                    const bf16_t* hp = HID + ((size_t)kv * 1024 + 4 * rg) * 256 + 128 * ch; const float* wp = a.in[12] + (size_t)kv * 256 * 128 + (size_t)(128 * ch) * 128 + d;
                    float s0 = 0.f, s1 = 0.f, s2 = 0.f, s3 = 0.f;
#pragma unroll 4
                    for (int c8 = 0; c8 < 16; ++c8) {
                        const u32x4 h0 = *(const u32x4*)(hp + 8 * c8), h1 = *(const u32x4*)(hp + 256 + 8 * c8), h2 = *(const u32x4*)(hp + 512 + 8 * c8), h3 = *(const u32x4*)(hp + 768 + 8 * c8);
#pragma unroll
                        for (int q = 0; q < 4; ++q) { const float w0 = wp[(size_t)(8 * c8 + 2 * q) * 128], w1 = wp[(size_t)(8 * c8 + 2 * q + 1) * 128];
                            s0 += bf_lo(h0[q]) * w0 + bf_hi(h0[q]) * w1; s1 += bf_lo(h1[q]) * w0 + bf_hi(h1[q]) * w1; s2 += bf_lo(h2[q]) * w0 + bf_hi(h2[q]) * w1; s3 += bf_lo(h3[q]) * w0 + bf_hi(h3[q]) * w1; }
                    }
                    s0 += __shfl_xor(s0, 1); s1 += __shfl_xor(s1, 1); s2 += __shfl_xor(s2, 1); s3 += __shfl_xor(s3, 1);
                    if (ch == 0) { bf16_t* kp = KCVC + ((size_t)kv * 1024 + 4 * rg) * 128 + d;
                        if ((rg & 31) == 31) s3 = 0.f;
                        kp[0] = (bf16_t)(pk_bf16(s0, 0.f) & 0xffffu); kp[128] = (bf16_t)(pk_bf16(s1, 0.f) & 0xffffu); kp[256] = (bf16_t)(pk_bf16(s2, 0.f) & 0xffffu); kp[384] = (bf16_t)(pk_bf16(s3, 0.f) & 0xffffu); }
                }
            }
            GSYNC();
            {
                for (int arep = 0; arep < 1 + PROBE_ATTX2; ++arep) for (;;) {
                    const int u = fetch_unit_x(ctl + 64 * 8 * (2 + 4 * arep), (int)xbar.x & 7, 32, slot);
                    if (u < 0) break;
                    const int qb = 31 - (u & 31), bg = u >> 5;
                    cmp_unit(lds, PBUF, KCVC, KCVC + (size_t)1024 * 128, OCMP, SEL, bg >> 1, bg & 1, qb);
                }
            }
            GSYNC();
            {
                AttnArgs as{}; as.Q = QR; as.ldq = 1024; as.qhs = 128; as.K = PBUF + 1536; as.ldk = HYBN; as.khs = 128; as.K2 = nullptr; as.ldk2 = 0; as.V = PBUF + 1792; as.ldv = HYBN; as.vhs = 128;
                as.O = OBUF; as.ldo = 2048; as.ocol0 = 0; as.sc2 = 0.08838834764831845f * LOG2E; as.cum2_ = CUM2; as.sel_ = SEL; as.P = PBUF; as.ocmp_ = OCMP; as.owin_ = OWIN;
                for (int arep = 0; arep < 1 + PROBE_ATTX2; ++arep) for (;;) {
                    const int u = fetch_unit_x(ctl + 64 * 8 * (3 + 4 * arep), (int)xbar.x & 7, 32, slot);
                    if (u < 0) break;
                    const int qb = 31 - (u & 31), bg = u >> 5;
                    attn_unit<3, 128, 4>(lds, as, bg >> 1, bg & 1, qb);
                }
                TJOBQ(1, a.in[2] + (size_t)2048 * 11264, 2048, 11264, 11264, a.in[1] + 2048, (bf16_t*)(ws + WS_W1T + (size_t)2 * 44 * MiB), ctl + 64 * 41, 6656, 11264);
            }
            GSYNC();
        }
        if (k == 2) {
            {
                pg8::Gemm g{XB, XB, MLAIN, M, MLAN, 2048, 2048, 1 << 30};
                pg8::StaticOrder S; S.init(M, MLAN, G, bid);
                pg8::EpiScale<8, true, 2> E{CB, MLAN, CB, MLAN, 1 << 30, SSQ, 0, 0, 1.f / 2048.f, SSQ2, ROPE64};
                pg8::gemm_phase<pg8::EpiScale<8, true, 2>, pg8::StaticOrder, true, true>(lds, g, S, E);
            }
            if (bid >= 160 && G == 256) {
                int tid_o = threadIdx.x; asm volatile("" : "+v"(tid_o)); const int lane = tid_o & 63, wave = __builtin_amdgcn_readfirstlane(tid_o >> 6);
                LAS float* scr = (LAS float*)(lds + wave * 16384);
                TJOBR(1, a.in[6] + (size_t)2048 * 11264, 2048, 11264, 11264, a.in[5] + 2048, (bf16_t*)(ws + WS_W1T + (size_t)3 * 44 * MiB), (bid - 160) * 8 + wave, 96 * 8, 1728, 9088);
            } else if (G != 256) {
                int tid_o = threadIdx.x; asm volatile("" : "+v"(tid_o)); const int lane = tid_o & 63, wave = __builtin_amdgcn_readfirstlane(tid_o >> 6);
                LAS float* scr = (LAS float*)(lds + wave * 16384);
                TJOBR(1, a.in[6] + (size_t)2048 * 11264, 2048, 11264, 11264, a.in[5] + 2048, (bf16_t*)(ws + WS_W1T + (size_t)3 * 44 * MiB), bid * 8 + wave, G * 8, 1728, 9088);
            }
            GSYNC();
            {
                pg8::Gemm g{CB, CB + 512, UQKV, M, 7168, 512, MLAN, 12};
                pg8::StaticOrder S; S.init(M, 7168, G, bid);
                pg8::EpiScale<2, false, 1> E{QBUF, 3072, KVBUF, 4096, 12, SSQ2, 0, 8, 1.f / 512.f, nullptr, ROPE64};
                pg8::gemm_phase<pg8::EpiScale<2, false, 1>, pg8::StaticOrder, true, true>(lds, g, S, E);
            }
            GSYNC();
            {
                AttnArgs am{}; am.Q = QBUF; am.ldq = 3072; am.qhs = 192; am.K = KVBUF; am.ldk = 4096; am.khs = 256; am.K2 = CB + 1024; am.ldk2 = MLAN; am.V = KVBUF + 128; am.ldv = 4096; am.vhs = 256;
                am.O = OBUF; am.ldo = 2048; am.ocol0 = 0; am.sc2 = 0.07216878364870322f * LOG2E; am.cum2_ = CUM2; am.sel_ = SEL; am.P = PBUF; am.ocmp_ = OCMP; am.owin_ = OWIN;
                for (int arep = 0; arep < 1 + PROBE_ATTX2; ++arep) for (;;) {
                    const int u = fetch_unit_x(ctl + 64 * 8 * (4 + 4 * arep), (int)xbar.x & 7, 64, slot);
                    if (u < 0) break;
                    const int x = u >> 6, v = u & 63; const int qb = 7 - (v >> 3), bh = x + 8 * (v & 7);
                    attn_unit<0, 192, 1>(lds, am, bh >> 4, bh & 15, qb);
                }
            }
            GSYNC();
        }
        if (k == 0 || k == 2) {
            pg8::Gemm g{OBUF, OBUF, k == 0 ? HYBOUT : MLAOUT, M, 2048, 2048, 2048, 1 << 30};
            pg8::StaticOrder S; S.init(M, 2048, G, bid);
            pg8::EpiResid E{X, X, XB, SSQ, 1.0f};
            pg8::gemm_phase<pg8::EpiResid, pg8::StaticOrder, true, true>(lds, g, S, E);
            GSYNC();
        }
    }
    {
                int tid_o = threadIdx.x; asm volatile("" : "+v"(tid_o)); const int tid = tid_o, lane = tid & 63, wave = __builtin_amdgcn_readfirstlane(tid >> 6), gw = bid * 8 + wave, gtid = bid * 512 + tid; (void)lane; (void)gw; (void)gtid;
    for (int m = gw; m < M; m += NGW) {
        float s = (lane < 32) ? SSQ[(size_t)m * 32 + lane] : 0.f; s = wave_sum(s);
        const float rs = rsqrtf(s * (1.f / 2048.f) + pg8::NORM_EPS);
        f32x4* xr = (f32x4*)(X + (size_t)m * D) + lane; const f32x4* gr = (const f32x4*)a.in[20] + lane;
#pragma unroll
        for (int j = 0; j < 8; ++j) { f32x4 v = xr[64 * j]; const f32x4 g4 = gr[64 * j]; v = v * rs * g4; xr[64 * j] = v; }
    }
    }    if (PROBE_TSMASK) {
        GSYNC();
        __threadfence(); __syncthreads();
        if (bid == 0) {
            const unsigned long long* ts = (const unsigned long long*)(a.ws + 65536); unsigned long long tot = 0;
            for (int n = 1; n <= 22; ++n) if ((PROBE_TSMASK >> n) & 1u) tot += ts[n] - ts[n - 1];
            if ((PROBE_TSMASK >> 23) & 1u) tot += ts[0] - ts[23];
            const float code = (float)tot * 10.0f;
            const float delta = sqrtf(code * 1.0246e-8f);
            for (int i = threadIdx.x; i < 16384; i += 512) X[i] += delta;
        }
    }
}

extern "C" void kernel_launch(void* const* d_in, const int* in_sizes, int n_in, void* d_out, int out_size, void* d_ws, size_t ws_size, hipStream_t stream) {
    static int grid = 0;
    if (grid == 0) {
        if (n_in != 21 || ws_size < WS_END) { fprintf(stderr, "kernel_launch: unexpected n_in %d or ws %zu (< %zu)\n", n_in, ws_size, (size_t)WS_END); grid = -1; return; }
        int dev = 0, cus = 0, per_cu = 0;
        hipGetDevice(&dev); hipDeviceGetAttribute(&cus, hipDeviceAttributeMultiprocessorCount, dev);
        if (hipFuncSetAttribute((const void*)mega_fwd, hipFuncAttributeMaxDynamicSharedMemorySize, LDS_BYTES) != hipSuccess) { fprintf(stderr, "hipFuncSetAttribute failed\n"); grid = -1; return; }
        if (hipOccupancyMaxActiveBlocksPerMultiprocessor(&per_cu, (const void*)mega_fwd, 512, LDS_BYTES) != hipSuccess || per_cu < 1) { fprintf(stderr, "occupancy query: %d\n", per_cu); per_cu = 1; }
        (void)hipGetLastError();
        grid = cus * 1;
    }
    if (grid < 0) return;
    if (hipMemsetAsync(d_ws, 0, 65536, stream) != hipSuccess) { fprintf(stderr, "memset of control words failed\n"); return; }
    Args a{};
    for (int i = 0; i < 21; ++i) a.in[i] = (const float*)d_in[i];
    a.out = (float*)d_out; a.ws = (unsigned char*)d_ws;
    void* args[] = {&a};
    hipError_t e = hipLaunchCooperativeKernel((const void*)mega_fwd, dim3(grid), dim3(512), args, LDS_BYTES, stream);
    if (e != hipSuccess) fprintf(stderr, "cooperative launch failed: %s (grid %d)\n", hipGetErrorString(e), grid);
}
```

```cpp
#include <hip/hip_runtime.h>
#include <hip/hip_cooperative_groups.h>
#include <cstdio>
#include <cstdint>
namespace cg = cooperative_groups;
#ifndef PROBE_SYNC2
#define PROBE_SYNC2 0
#endif
#ifndef PROBE_TSMASK
#define PROBE_TSMASK 0u
#endif
#ifndef PROBE_UPX2
#define PROBE_UPX2 0
#endif
#ifndef PROBE_ATTX2
#define PROBE_ATTX2 0
#endif
#ifndef PROBE_P0X2
#define PROBE_P0X2 0
#endif
#define GSYNC() do { xcd_barrier(xbar); if (PROBE_SYNC2) xcd_barrier(xbar); if (PROBE_TSMASK) { ++ts_idx; if (blockIdx.x == 0 && threadIdx.x == 0) ((unsigned long long*)(a.ws + 65536))[ts_idx] = __builtin_amdgcn_s_memrealtime(); } } while (0)
namespace pg8 {
#define PG8_LAS __attribute__((address_space(3)))
typedef unsigned short bf16_t;
typedef short bf16x8 __attribute__((ext_vector_type(8)));
typedef float f32x4 __attribute__((ext_vector_type(4)));
typedef unsigned u32x4 __attribute__((ext_vector_type(4)));
constexpr int BM = 256, BK = 64, HALF = 128, HTB = HALF * BK * 2  , STAGE_BYTES = 8 * HTB, NXCD = 8, WGM = 8;

__host__ __device__ __forceinline__ int lds_byte(int r, int c) { const int st = (r >> 4) * 2 + (c >> 5), rr = r & 15, cc = c & 31, ob = rr * 64 + cc * 2; return st * 1024 + (ob ^ (((ob >> 9) & 1) << 5)); }
__host__ __device__ __forceinline__ void stage_rc(int b, int& R, int& C) { const int st = b / 1024, sb = b % 1024, swz = sb ^ (((sb >> 9) & 1) << 5); R = (st >> 1) * 16 + swz / 64; C = (st & 1) * 32 + (swz % 64) / 2; }
__host__ __device__ __forceinline__ int perm32(int rho) { const int n = rho >> 4, i = rho & 15; return 8 * (i >> 2) + 4 * n + (i & 3); }

struct Unit { int pm, pn; };

struct StaticOrder {
    int nM, nN, nwg, G, c;
    __host__ __device__ void init(int M, int N, int G_, int c_) { nM = M / BM; nN = N / BM; nwg = nM * nN; G = G_; c = c_; }
    __host__ __device__ bool next(int i, Unit& u) const {
        const long L = (long)i * G + c; if (L >= nwg) return false;
        int wgid = (int)L; { const int q = nwg / NXCD, r = nwg % NXCD, xcd = wgid % NXCD, off = wgid / NXCD; wgid = (xcd < r ? xcd * (q + 1) : r * (q + 1) + (xcd - r) * q) + off; }
        const int nig = WGM * nN, gid = wgid / nig, fm = gid * WGM, gsz = (nM - fm) < WGM ? (nM - fm) : WGM;
        u.pm = fm + ((wgid % nig) % gsz); u.pn = (wgid % nig) / gsz; return true;
    }
    __device__ __forceinline__ void a_ready(const Unit&) const {}
    __device__ __forceinline__ void done(const Unit&) const {}
};

struct Gemm { const bf16_t* A; const bf16_t* A2; const bf16_t* Bt; int M, N, K, lda, pn2; };
struct ListOrder {
    int nM, nwg, G, c;
    __device__ void init(int M, int N, int G_, int c_) { nM = M / BM; nwg = nM * (N / BM); G = G_; c = c_; }
    __device__ bool next(int i, Unit& u) const { const long L = (long)i * G + c; if (L >= nwg) return false; u.pm = (int)L % nM; u.pn = (int)L / nM; return true; }
    __device__ __forceinline__ void a_ready(const Unit&) const {}
    __device__ __forceinline__ void done(const Unit&) const {}
};
typedef __bf16 bf16x2v __attribute__((ext_vector_type(2)));
typedef float f32x2v __attribute__((ext_vector_type(2)));
typedef unsigned u32x2 __attribute__((ext_vector_type(2)));
__device__ __forceinline__ unsigned pk_bf16(float lo, float hi) { f32x2v f = {lo, hi}; return __builtin_bit_cast(unsigned, __builtin_convertvector(f, bf16x2v)); }
__device__ __forceinline__ float bf_lo(unsigned u) { return __uint_as_float(u << 16); }
__device__ __forceinline__ float bf_hi(unsigned u) { return __uint_as_float(u & 0xffff0000u); }
__device__ __forceinline__ float bf2f(bf16_t v) { return __uint_as_float(((unsigned)v) << 16); }

constexpr float NORM_EPS = 1e-6f;
template <int PER> __device__ __forceinline__ float row_rstd(const float* ssq, int off, float invn, int row, int fq) {
    const float* p = ssq + (size_t)row * 32 + off + fq * PER; float s = 0.f;
#pragma unroll
    for (int i = 0; i < PER; ++i) s += p[i];
    s += __shfl_xor(s, 16); s += __shfl_xor(s, 32);
    return rsqrtf(s * invn + NORM_EPS);
}
__device__ __forceinline__ float silu_f(float g) { return g * __builtin_amdgcn_rcpf(1.f + __expf(-g)); }
__device__ __forceinline__ float gelu_tanh_f(float x) { const float u = 0.7978845608028654f * (x + 0.044715f * x * x * x); const float e = __expf(2.f * u); const float th = 1.f - 2.f * __builtin_amdgcn_rcpf(1.f + e); return 0.5f * x * (1.f + th); }

struct EpiSwiglu {
    static constexpr bool PERM = true, AFTER_DRAIN = false;
    bf16_t* O; int ldc; const float* ssq;
    __device__ __forceinline__ void operator()(const f32x4 (&acc)[2][2][4][2], const Unit& u, int wr, int wc, int fr, int fq) const {
        const int row0 = u.pm * BM + wr * 64 + fr, col0 = u.pn * 128 + wc * 32 + 8 * fq;
        float rsv[2][4];
#pragma unroll
        for (int ai = 0; ai < 2; ++ai)
#pragma unroll
            for (int m = 0; m < 4; ++m) rsv[ai][m] = row_rstd<8>(ssq, 0, 1.f / 2048.f, row0 + ai * HALF + m * 16, fq);
#pragma unroll
        for (int ai = 0; ai < 2; ++ai)
#pragma unroll
            for (int m = 0; m < 4; ++m) {
                const int row = row0 + ai * HALF + m * 16; const float rs = rsv[ai][m];
                f32x4 v0, v1;
#pragma unroll
                for (int j = 0; j < 4; ++j) { v0[j] = silu_f(acc[ai][0][m][0][j] * rs) * (acc[ai][1][m][0][j] * rs); v1[j] = silu_f(acc[ai][0][m][1][j] * rs) * (acc[ai][1][m][1][j] * rs); }
                u32x4 w; w.x = pk_bf16(v0[0], v0[1]); w.y = pk_bf16(v0[2], v0[3]); w.z = pk_bf16(v1[0], v1[1]); w.w = pk_bf16(v1[2], v1[3]);
                *(u32x4*)(O + (size_t)row * ldc + col0) = w;
            }
    }
};
template <int PER, bool SSQ_OUT, int ROPE = 0> struct EpiScale {
    static constexpr bool PERM = true, AFTER_DRAIN = false;
    bf16_t* O; int ldc; bf16_t* O2; int ldc2; int pn2; const float* ssq; int soff, soff2; float invn; float* ssq_out; const float* rope;
    __device__ __forceinline__ void operator()(const f32x4 (&acc)[2][2][4][2], const Unit& u, int wr, int wc, int fr, int fq) const {
        const int row0 = u.pm * BM + wr * 64 + fr; const bool second = u.pn >= pn2;
        bf16_t* base = second ? O2 : O; const int ld = second ? ldc2 : ldc; const int so = second ? soff2 : soff;
        const int col0 = (second ? u.pn - pn2 : u.pn) * BM + wc * 32 + 8 * fq;
        float rsv[2][4];
#pragma unroll
        for (int ai = 0; ai < 2; ++ai)
#pragma unroll
            for (int m = 0; m < 4; ++m) rsv[ai][m] = row_rstd<PER>(ssq, so, invn, row0 + ai * HALF + m * 16, fq);
#pragma unroll
        for (int ai = 0; ai < 2; ++ai)
#pragma unroll
            for (int m = 0; m < 4; ++m) {
                const int row = row0 + ai * HALF + m * 16; const float rs = rsv[ai][m];
                float sq = 0.f;
#pragma unroll
                for (int bj = 0; bj < 2; ++bj) { f32x4 v0 = acc[ai][bj][m][0] * rs, v1 = acc[ai][bj][m][1] * rs;
                    if (ROPE != 0) { const int cc = col0 + bj * HALF; int i0 = -1;
                        if (ROPE == 1) { if (!second) { const int c192 = cc % 192; if (c192 >= 128) i0 = (c192 - 128) >> 1; } }
                        else { if (cc >= 1024 && cc < 1088) i0 = (cc - 1024) >> 1; }
                        if (i0 >= 0) { const float* rp = rope + ((size_t)(row & 2047) * 32 + i0) * 2; const f32x4 c0 = *(const f32x4*)rp, c1 = *(const f32x4*)(rp + 4);
                            const f32x4 a0 = v0, a1 = v1;
                            v0[0] = a0[0] * c0[0] - a0[1] * c0[1]; v0[1] = a0[1] * c0[0] + a0[0] * c0[1]; v0[2] = a0[2] * c0[2] - a0[3] * c0[3]; v0[3] = a0[3] * c0[2] + a0[2] * c0[3];
                            v1[0] = a1[0] * c1[0] - a1[1] * c1[1]; v1[1] = a1[1] * c1[0] + a1[0] * c1[1]; v1[2] = a1[2] * c1[2] - a1[3] * c1[3]; v1[3] = a1[3] * c1[2] + a1[2] * c1[3]; } }
                    if (SSQ_OUT) sq += (v0[0] * v0[0] + v0[1] * v0[1]) + (v0[2] * v0[2] + v0[3] * v0[3]) + (v1[0] * v1[0] + v1[1] * v1[1]) + (v1[2] * v1[2] + v1[3] * v1[3]);
                    u32x4 w; w.x = pk_bf16(v0[0], v0[1]); w.y = pk_bf16(v0[2], v0[3]); w.z = pk_bf16(v1[0], v1[1]); w.w = pk_bf16(v1[2], v1[3]);
                    *(u32x4*)(base + (size_t)row * ld + col0 + bj * HALF) = w; }
                if (SSQ_OUT) { sq += __shfl_xor(sq, 16); sq += __shfl_xor(sq, 32); if (fq == 0) ssq_out[(size_t)row * 32 + u.pn * 4 + wc] = sq; }
            }
    }
};
struct EpiResid {
    static constexpr bool PERM = false, AFTER_DRAIN = false;
    const float* base; float* out; bf16_t* xb; float* ssq; float c;
    __device__ __forceinline__ void operator()(const f32x4 (&acc)[2][2][4][2], const Unit& u, int wr, int wc, int fr, int fq) const {
        const int row0 = u.pm * BM + wr * 64 + fr, col0 = u.pn * BM + wc * 32 + 4 * fq;
        f32x4 bv[8][2][2];
#define RES_LD(g) do { const size_t ro_ = (size_t)(row0 + ((g) >> 2) * HALF + ((g) & 3) * 16) * 2048 + col0; \
        _Pragma("unroll") for (int bj = 0; bj < 2; ++bj) _Pragma("unroll") for (int n = 0; n < 2; ++n) bv[g][bj][n] = *(const f32x4*)(base + ro_ + bj * HALF + n * 16); } while (0)
        RES_LD(0); RES_LD(1); RES_LD(2);
#pragma unroll
        for (int g = 0; g < 8; ++g) {
            const int ai = g >> 2, m = g & 3; const int row = row0 + ai * HALF + m * 16; float sq = 0.f;
#pragma unroll
            for (int bj = 0; bj < 2; ++bj)
#pragma unroll
                for (int n = 0; n < 2; ++n) { const size_t off = (size_t)row * 2048 + col0 + bj * HALF + n * 16;
                    const f32x4 v = bv[g][bj][n] + acc[ai][bj][m][n] * c;
                    *(f32x4*)(out + off) = v; sq += (v[0] * v[0] + v[1] * v[1]) + (v[2] * v[2] + v[3] * v[3]);
                    u32x2 w; w.x = pk_bf16(v[0], v[1]); w.y = pk_bf16(v[2], v[3]); *(u32x2*)(xb + off) = w; }
            sq += __shfl_xor(sq, 16); sq += __shfl_xor(sq, 32); if (fq == 0) ssq[(size_t)row * 32 + u.pn * 4 + wc] = sq;
            if (g + 3 < 8) { switch (g + 3) { case 3: RES_LD(3); break; case 4: RES_LD(4); break; case 5: RES_LD(5); break; case 6: RES_LD(6); break; default: RES_LD(7); break; } }
        }
#undef RES_LD
    }
};
struct EpiGelu {
    static constexpr bool PERM = true, AFTER_DRAIN = false;
    bf16_t* HID; const float* bias;
    __device__ __forceinline__ void operator()(const f32x4 (&acc)[2][2][4][2], const Unit& u, int wr, int wc, int fr, int fq) const {
        const int row0 = u.pm * BM + wr * 64 + fr, col0 = wc * 32 + 8 * fq;
        f32x4 bb[2][2];
#pragma unroll
        for (int bj = 0; bj < 2; ++bj) { const float* bp = bias + u.pn * 256 + col0 + bj * HALF; bb[bj][0] = *(const f32x4*)bp; bb[bj][1] = *(const f32x4*)(bp + 4); }
#pragma unroll
        for (int ai = 0; ai < 2; ++ai)
#pragma unroll
            for (int m = 0; m < 4; ++m) { const int row = row0 + ai * HALF + m * 16;
#pragma unroll
                for (int bj = 0; bj < 2; ++bj) { float v[8];
#pragma unroll
                    for (int j = 0; j < 4; ++j) { v[j] = gelu_tanh_f(acc[ai][bj][m][0][j] + bb[bj][0][j]); v[4 + j] = gelu_tanh_f(acc[ai][bj][m][1][j] + bb[bj][1][j]); }
                    u32x4 w; w.x = pk_bf16(v[0], v[1]); w.y = pk_bf16(v[2], v[3]); w.z = pk_bf16(v[4], v[5]); w.w = pk_bf16(v[6], v[7]);
                    *(u32x4*)(HID + ((size_t)u.pn * 1024 + row) * 256 + col0 + bj * HALF) = w; } }
    }
};
template <class Epi, class Sched, bool ALIGN_EPI = false, bool SP2 = false>
__device__ __forceinline__ void gemm_phase(PG8_LAS unsigned char* lds, const Gemm g, const Sched& S, const Epi& E) {
    int tid_op = threadIdx.x; asm volatile("" : "+v"(tid_op));
    const int tid = tid_op, wid = __builtin_amdgcn_readfirstlane(tid >> 6), lane = tid & 63, wr = wid >> 2, wc = wid & 3, fr = lane & 15, fq = lane >> 4;
    const int K = g.K, nt = K / BK;
    unsigned voffA[2], voffB[2];
#pragma unroll
    for (int i = 0; i < 2; ++i) { int R, C; stage_rc(tid * 16 + i * 8192, R, C); const int Rb = Epi::PERM ? ((R & ~31) + perm32(R & 31)) : R;
        voffA[i] = (unsigned)(R * g.lda + C) * 2u; voffB[i] = (unsigned)(Rb * K + C) * 2u; }
    const size_t kstep = (size_t)(BK * 2);
    const size_t hstepB = (size_t)HALF * K * 2, hstepA = (size_t)HALF * g.lda * 2;
    const size_t tstepA = 2 * hstepA, tstepB = 2 * hstepB;
    const unsigned ldsw = (unsigned)wid * 1024u;
    const int aoff = lds_byte(wr * 64 + fr, fq * 8), boff = lds_byte(wc * 32 + fr, fq * 8);
#define PG8_SA(b, h) (((b) * 2 + (h)) * HTB)
#define PG8_SB(b, h) ((4 + (b) * 2 + (h)) * HTB)
#define PG8_STAGE(bufoff, gbase, voff) do { _Pragma("unroll") for (int _i = 0; _i < 2; ++_i) \
        __builtin_amdgcn_global_load_lds((const unsigned*)((const char*)(gbase) + (voff)[_i]), (PG8_LAS unsigned*)(lds + (bufoff) + ldsw + _i * 8192), 16, 0, 0); } while (0)
#define PG8_LDA(dst, b, h) do { _Pragma("unroll") for (int m = 0; m < 4; ++m) _Pragma("unroll") for (int k = 0; k < 2; ++k) dst[m][k] = *(const PG8_LAS bf16x8*)(lds + PG8_SA(b, h) + aoff + m * 2048 + k * 1024); } while (0)
#define PG8_LDB(dst, b, h) do { _Pragma("unroll") for (int n = 0; n < 2; ++n) _Pragma("unroll") for (int k = 0; k < 2; ++k) dst[n][k] = *(const PG8_LAS bf16x8*)(lds + PG8_SB(b, h) + boff + n * 2048 + k * 1024); } while (0)
#define PG8_MMA(ai, bj, At, Bt) do { __builtin_amdgcn_s_setprio(1); _Pragma("unroll") for (int m = 0; m < 4; ++m) _Pragma("unroll") for (int n = 0; n < 2; ++n) _Pragma("unroll") for (int k = 0; k < 2; ++k) \
        acc[ai][bj][m][n] = __builtin_amdgcn_mfma_f32_16x16x32_bf16(Bt[n][k], At[m][k], acc[ai][bj][m][n], 0, 0, 0); __builtin_amdgcn_s_setprio(0); } while (0)
#define PG8_WAIT_V(n) asm volatile("s_waitcnt vmcnt(" #n ")" ::: "memory")
#define PG8_WAIT_L(n) asm volatile("s_waitcnt lgkmcnt(" #n ")" ::: "memory")
#define PG8_BAR __builtin_amdgcn_s_barrier()
#define PG8_SCHED __builtin_amdgcn_sched_barrier(0)
    Unit cur, nxt; int ui = 0;
    if (!S.next(0, cur)) return;
    f32x4 acc[2][2][4][2];
#pragma unroll
    for (int a = 0; a < 2; ++a)
#pragma unroll
        for (int b = 0; b < 2; ++b)
#pragma unroll
            for (int m = 0; m < 4; ++m)
#pragma unroll
                for (int n = 0; n < 2; ++n) acc[a][b][m][n] = (f32x4){0.f, 0.f, 0.f, 0.f};
    bf16x8 At[4][2], B0[2][2], B1[2][2];
    const char* cA = (const char*)(cur.pn >= g.pn2 ? g.A2 : g.A) + (size_t)cur.pm * tstepA; const char* cB = (const char*)g.Bt + (size_t)cur.pn * tstepB;
    S.a_ready(cur);
    if constexpr (SP2) {
        PG8_STAGE(PG8_SB(0, 0), cB, voffB); PG8_STAGE(PG8_SB(0, 1), cB + hstepB, voffB); PG8_STAGE(PG8_SA(0, 0), cA, voffA); PG8_STAGE(PG8_SA(0, 1), cA + hstepA, voffA);
        if (wr == 1) PG8_BAR;
        PG8_WAIT_V(2); PG8_BAR;
        PG8_STAGE(PG8_SB(1, 0), cB + kstep, voffB); PG8_STAGE(PG8_SA(1, 0), cA + kstep, voffA); PG8_STAGE(PG8_SB(1, 1), cB + hstepB + kstep, voffB);
        PG8_WAIT_V(6); PG8_BAR;
    } else {
        PG8_STAGE(PG8_SB(0, 0), cB, voffB); PG8_STAGE(PG8_SA(0, 0), cA, voffA); PG8_STAGE(PG8_SB(0, 1), cB + hstepB, voffB); PG8_STAGE(PG8_SA(0, 1), cA + hstepA, voffA);
        if (wr == 1) PG8_BAR;
        PG8_WAIT_V(4); PG8_BAR;
        PG8_STAGE(PG8_SB(1, 0), cB + kstep, voffB); PG8_STAGE(PG8_SA(1, 0), cA + kstep, voffA); PG8_STAGE(PG8_SB(1, 1), cB + hstepB + kstep, voffB);
        PG8_WAIT_V(6); PG8_BAR;
    }
    for (;;) {
        const bool has_next = S.next(ui + 1, nxt);
        const char* nA = has_next ? (const char*)(nxt.pn >= g.pn2 ? g.A2 : g.A) + (size_t)nxt.pm * tstepA : cA; const char* nB = has_next ? (const char*)g.Bt + (size_t)nxt.pn * tstepB : cB;
        for (int t = 0; t < nt; t += 2) {
            const bool last = (t == nt - 2);
            const char* a1 = cA + (size_t)(t + 1) * kstep;
            const char* a2 = last ? nA : cA + (size_t)(t + 2) * kstep; const char* b2 = last ? nB : cB + (size_t)(t + 2) * kstep;
            const char* a3 = a2 + kstep; const char* b3 = b2 + kstep;
            if (last && has_next) S.a_ready(nxt);
            if constexpr (SP2) {
            PG8_LDB(B0, 0, 0); PG8_LDB(B1, 0, 1); PG8_SCHED; PG8_LDA(At, 0, 0); PG8_STAGE(PG8_SA(1, 1), a1 + hstepA, voffA);
            PG8_WAIT_V(8); PG8_WAIT_L(0); PG8_BAR; PG8_MMA(0, 0, At, B0); PG8_MMA(0, 1, At, B1); PG8_BAR; PG8_SCHED;
            PG8_LDA(At, 0, 1); PG8_STAGE(PG8_SB(0, 0), b2, voffB); PG8_STAGE(PG8_SB(0, 1), b2 + hstepB, voffB); PG8_STAGE(PG8_SA(0, 0), a2, voffA);
            PG8_WAIT_V(8); PG8_WAIT_L(0); PG8_BAR; PG8_MMA(1, 0, At, B0); PG8_MMA(1, 1, At, B1); PG8_BAR; PG8_SCHED;
            PG8_LDB(B0, 1, 0); PG8_LDB(B1, 1, 1); PG8_SCHED; PG8_LDA(At, 1, 0); PG8_STAGE(PG8_SA(0, 1), a2 + hstepA, voffA);
            PG8_WAIT_V(8); PG8_WAIT_L(0); PG8_BAR; PG8_MMA(0, 0, At, B0); PG8_MMA(0, 1, At, B1); PG8_BAR; PG8_SCHED;
            PG8_LDA(At, 1, 1); PG8_STAGE(PG8_SB(1, 0), b3, voffB); PG8_STAGE(PG8_SB(1, 1), b3 + hstepB, voffB); PG8_STAGE(PG8_SA(1, 0), a3, voffA);
            PG8_WAIT_V(8); PG8_WAIT_L(0); PG8_BAR; PG8_MMA(1, 0, At, B0); PG8_MMA(1, 1, At, B1); PG8_BAR; PG8_SCHED;
            } else {
            PG8_LDB(B0, 0, 0); PG8_SCHED; PG8_LDA(At, 0, 0); PG8_STAGE(PG8_SA(1, 1), a1 + hstepA, voffA);
            PG8_WAIT_L(8); PG8_BAR; PG8_WAIT_L(0); PG8_MMA(0, 0, At, B0); PG8_BAR; PG8_SCHED;
            PG8_LDB(B1, 0, 1); PG8_STAGE(PG8_SB(0, 0), b2, voffB);
            PG8_BAR; PG8_WAIT_L(0); PG8_MMA(0, 1, At, B1); PG8_BAR;
            PG8_LDA(At, 0, 1); PG8_STAGE(PG8_SA(0, 0), a2, voffA);
            PG8_BAR; PG8_WAIT_L(0); PG8_MMA(1, 0, At, B0); PG8_BAR; PG8_SCHED;
            PG8_STAGE(PG8_SB(0, 1), b2 + hstepB, voffB);
            PG8_WAIT_V(6); PG8_BAR; PG8_MMA(1, 1, At, B1); PG8_BAR;
            PG8_LDB(B0, 1, 0); PG8_SCHED; PG8_LDA(At, 1, 0); PG8_STAGE(PG8_SA(0, 1), a2 + hstepA, voffA);
            PG8_WAIT_L(8); PG8_BAR; PG8_WAIT_L(0); PG8_MMA(0, 0, At, B0); PG8_BAR; PG8_SCHED;
            PG8_LDB(B1, 1, 1); PG8_STAGE(PG8_SB(1, 0), b3, voffB);
            PG8_BAR; PG8_WAIT_L(0); PG8_MMA(0, 1, At, B1); PG8_BAR;
            PG8_LDA(At, 1, 1); PG8_STAGE(PG8_SA(1, 0), a3, voffA);
            PG8_BAR; PG8_WAIT_L(0); PG8_MMA(1, 0, At, B0); PG8_BAR; PG8_SCHED;
            PG8_STAGE(PG8_SB(1, 1), b3 + hstepB, voffB);
            PG8_WAIT_V(6); PG8_BAR; PG8_MMA(1, 1, At, B1); PG8_BAR;
            }
        }
        if constexpr (ALIGN_EPI) { if (wr == 0) PG8_BAR; }
        if constexpr (!Epi::AFTER_DRAIN) { E(acc, cur, wr, wc, fr, fq); S.done(cur); }
        if (!has_next) break;
#pragma unroll
        for (int a = 0; a < 2; ++a)
#pragma unroll
            for (int b = 0; b < 2; ++b)
#pragma unroll
                for (int m = 0; m < 4; ++m)
#pragma unroll
                    for (int n = 0; n < 2; ++n) acc[a][b][m][n] = (f32x4){0.f, 0.f, 0.f, 0.f};
        cur = nxt; cA = nA; cB = nB; ++ui;
        if constexpr (ALIGN_EPI) { if (wr == 1) PG8_BAR; }
    }
    PG8_WAIT_V(0);
    if constexpr (!ALIGN_EPI) { if (wr == 0) PG8_BAR; }
    PG8_BAR;
    if constexpr (Epi::AFTER_DRAIN) { E.fused(acc, cur, wr, wc, fr, fq, lds, wid, lane); S.done(cur); }
#undef PG8_SA
#undef PG8_SB
#undef PG8_STAGE
#undef PG8_LDA
#undef PG8_LDB
#undef PG8_MMA
#undef PG8_WAIT_V
#undef PG8_WAIT_L
#undef PG8_BAR
#undef PG8_SCHED
}
}
#define LAS __attribute__((address_space(3)))
typedef unsigned short bf16_t;
typedef short bf16x8 __attribute__((ext_vector_type(8)));
typedef short s16x4 __attribute__((ext_vector_type(4)));
typedef float f32x4 __attribute__((ext_vector_type(4)));
typedef float f32x16 __attribute__((ext_vector_type(16)));
typedef unsigned u32x4 __attribute__((ext_vector_type(4)));
using pg8::u32x2; using pg8::pk_bf16; using pg8::bf_lo; using pg8::bf_hi; using pg8::bf2f;
constexpr int T = 2048, NB = 4, M = NB * T, D = 2048, DFF = 5632, HYBN = 5888, MLAN = 1280;
constexpr size_t MiB = 1u << 20;
constexpr size_t WS_CTL = 0, WS_SSQ = 1 * MiB, WS_SSQ2 = 2 * MiB, WS_CUM = 3 * MiB, WS_SEL = 3 * MiB + 256 * 1024, WS_BPART = 3 * MiB + 512 * 1024, WS_BIASPE = 3 * MiB + 768 * 1024,
                 WS_ROPE128 = 4 * MiB, WS_ROPE64 = 5 * MiB, WS_HID = 6 * MiB, WS_KCVC = 7 * MiB;
constexpr size_t WS_W1T = 8 * MiB, WS_W2T = 184 * MiB, WS_HYBIN = 272 * MiB, WS_HYBOUT = 295 * MiB, WS_MLAIN = 303 * MiB, WS_UQKV = 308 * MiB, WS_MLAOUT = 315 * MiB, WS_CMPW1 = 323 * MiB;
constexpr size_t WS_XB = 327 * MiB, WS_ACT = 359 * MiB, WS_OBUF = 447 * MiB, WS_MIX = 479 * MiB;
constexpr size_t WS_PBUF = WS_MIX, WS_QR = WS_MIX + 92 * MiB, WS_CMPIN = WS_MIX + 108 * MiB, WS_OWIN = WS_MIX + 117 * MiB, WS_OCMP = WS_MIX + 133 * MiB;
constexpr size_t WS_C = WS_MIX, WS_QBUF = WS_MIX + 20 * MiB, WS_KVBUF = WS_MIX + 68 * MiB;
constexpr size_t WS_END = WS_MIX + 149 * MiB;
constexpr int LDS_BYTES = 147456, MISC_OFF = 131072;
constexpr float LOG2E = 1.4426950408889634f;

struct Args { const float* in[21]; float* out; unsigned char* ws; };

__device__ __forceinline__ float wave_sum(float v) {
#pragma unroll
    for (int o = 1; o < 64; o <<= 1) v += __shfl_xor(v, o);
    return v;
}
template <int MODE> __device__ __forceinline__ int mapcol(int n, int N) {
    if (MODE == 0) return n < N ? n : -1;
    if (MODE == 1) { const int t = n >> 8, r = n & 255; return r < 128 ? 128 * t + r : DFF + 128 * t + (r - 128); }
    if (MODE == 2) { if (n < 2560) return n; if (n < 5632) return n + 24; if (n < 5656) return 2560 + (n - 5632); if (n < 5664) return n; return -1; }
    if (MODE == 3) { const int h = n / 192, c = n % 192; if (c < 128) return n; const int p = c - 128; return h * 192 + 128 + (p >> 1) + 32 * (p & 1); }
    if (MODE == 4) { if (n < 1024) return n; if (n < 1088) { const int p = n - 1024; return 1024 + (p >> 1) + 32 * (p & 1); } return -1; }
    return -1;
}
template <int MODE> __device__ __forceinline__ void transpose_item(const float* W, int K, int N, int NP, const float* gain, bf16_t* WT, LAS float* scr, int item, int lane) {
    const int nblk = NP / 32, kb = item / nblk, nb = item % nblk, k0 = 64 * kb, n0 = 32 * nb;
    const int sc = mapcol<MODE>(n0 + (lane & 31), N);
    float v[32];
#pragma unroll
    for (int i = 0; i < 32; ++i) { const int kk = 2 * i + (lane >> 5); v[i] = (sc >= 0) ? __builtin_nontemporal_load(W + (size_t)(k0 + kk) * N + sc) : 0.f; }
    if (gain) {
#pragma unroll
        for (int i = 0; i < 32; ++i) v[i] *= gain[k0 + 2 * i + (lane >> 5)]; }
#pragma unroll
    for (int i = 0; i < 32; ++i) scr[(2 * i + (lane >> 5)) * 33 + (lane & 31)] = v[i];
    asm volatile("s_waitcnt lgkmcnt(0)" ::: "memory");
    const int c = lane & 7;
#pragma unroll
    for (int j = 0; j < 4; ++j) { const int n = (lane >> 3) + 8 * j; const LAS float* s = scr + (8 * c) * 33 + n;
        u32x4 o; o.x = pk_bf16(s[0 * 33], s[1 * 33]); o.y = pk_bf16(s[2 * 33], s[3 * 33]); o.z = pk_bf16(s[4 * 33], s[5 * 33]); o.w = pk_bf16(s[6 * 33], s[7 * 33]);
        *(u32x4*)(WT + (size_t)(n0 + n) * K + k0 + 8 * c) = o; }
    asm volatile("s_waitcnt lgkmcnt(0)" ::: "memory");
}
#define XB_TMO      128
#define XB_XCNT(j)  (256  + 64 * (j))
#define XB_XSUB(j)  (1280 + 64 * (j))
#define XB_XGEN(j)  (2304 + 64 * (j))
#define XB_TOP      3328
#define XB_TOPGEN   3392
#define XCD_BAR_WORDS 3456
#define XB_SPIN_CAP (1u << 18)

__device__ __forceinline__ unsigned xb_ld(unsigned* p)              { return __hip_atomic_load(p, __ATOMIC_RELAXED, __HIP_MEMORY_SCOPE_AGENT); }
__device__ __forceinline__ unsigned xb_add(unsigned* p, unsigned v) { return __hip_atomic_fetch_add(p, v, __ATOMIC_RELAXED, __HIP_MEMORY_SCOPE_AGENT); }
__device__ __forceinline__ unsigned xb_xcc_id() { return (unsigned)__builtin_amdgcn_s_getreg((3 << 11) | 20) & 0xFu; }
#define XB_SPIN(cond, bar) do { unsigned _sp = 0; while (cond) { __builtin_amdgcn_s_sleep(1); \
    if ((++_sp & 255u) == 0u) { if (xb_ld(&(bar)[XB_TMO])) break; if (_sp > XB_SPIN_CAP) { atomicAdd(&(bar)[XB_TMO], 1u); break; } } } } while (0)

struct XcdBarrier {
    unsigned* bar; unsigned x;
    volatile LAS unsigned* st;
};

__device__ __forceinline__ XcdBarrier xcd_barrier_post(unsigned* bar, volatile LAS unsigned* st) {
    XcdBarrier b; b.bar = bar; b.x = xb_xcc_id(); b.st = st;
    if (threadIdx.x == 0) (void)xb_add(&bar[XB_XCNT(b.x)], 1u);
    return b;
}
__device__ __forceinline__ void xcd_barrier_complete(unsigned* bar, unsigned x, unsigned& nloc, unsigned& nx) {
    const unsigned G = gridDim.x * gridDim.y * gridDim.z;
    unsigned sum, cnt, mine, sp = 0u;
    for (;;) {
        sum = 0u; cnt = 0u; mine = 0u;
#pragma unroll
        for (unsigned j = 0; j < 16; ++j) { const unsigned c = xb_ld(&bar[XB_XCNT(j)]); sum += c; cnt += (c > 0u) ? 1u : 0u; mine = (j == x) ? c : mine; }
        if (sum == G) break;
        __builtin_amdgcn_s_sleep(1);
        if ((++sp & 255u) == 0u) { if (xb_ld(&bar[XB_TMO])) break; if (sp > XB_SPIN_CAP) { atomicAdd(&bar[XB_TMO], 1u); break; } }
    }
    nloc = mine > 0u ? mine : 1u; nx = cnt > 0u ? cnt : 1u;
}

__device__ __forceinline__ void xcd_barrier(const XcdBarrier& b) {
    asm volatile("s_waitcnt vmcnt(0)" ::: "memory");
    __syncthreads();
    if (threadIdx.x == 0) {
        unsigned* bar = b.bar; unsigned xx = __builtin_amdgcn_readfirstlane(b.x); asm volatile("" : "+s"(xx));
        __builtin_amdgcn_s_waitcnt(0);
        unsigned nloc = b.st[0], nx = b.st[1];
        if (nloc == 0u) { xcd_barrier_complete(bar, xx, nloc, nx); b.st[0] = nloc; b.st[1] = nx; }
        const unsigned old = xb_add(&bar[XB_XSUB(xx)], 1u);
        const unsigned gen = old / nloc;
        if (old + 1u == (gen + 1u) * nloc) {
            __builtin_amdgcn_fence(__ATOMIC_RELEASE, "agent");
            asm volatile("s_waitcnt vmcnt(0)" ::: "memory");
            const unsigned og = xb_add(&bar[XB_TOP], 1u);
            const unsigned tg = og / nx;
            if (og + 1u == (tg + 1u) * nx) xb_add(&bar[XB_TOPGEN], 1u);
            else XB_SPIN(xb_ld(&bar[XB_TOPGEN]) == tg, bar);
            __builtin_amdgcn_fence(__ATOMIC_ACQUIRE, "agent");
            xb_add(&bar[XB_XGEN(xx)], 1u);
            asm volatile("s_waitcnt vmcnt(0)" ::: "memory");
        } else {
            XB_SPIN(xb_ld(&bar[XB_XGEN(xx)]) == gen, bar);
            __builtin_amdgcn_fence(__ATOMIC_ACQUIRE, "agent");
            asm volatile("s_waitcnt vmcnt(0)" ::: "memory");
        }
    }
    __syncthreads();
}

#define MFMA32(a, b, c) __builtin_amdgcn_mfma_f32_32x32x16_bf16((a), (b), (c), 0, 0, 0)
__device__ __forceinline__ s16x4 tr_read(LAS unsigned char* p) { return __builtin_amdgcn_ds_read_tr16_b64_v4i16((LAS s16x4*)p); }
__device__ __forceinline__ float fast_exp2(float x) { return __builtin_amdgcn_exp2f(x); }
__device__ __forceinline__ float sigmoid_f(float x) { return __builtin_amdgcn_rcpf(1.f + __expf(-x)); }
constexpr int KP128 = 272, KP192 = 400, VP = 320;
struct AttnArgs {
    const bf16_t* Q; int ldq, qhs;
    const bf16_t* K; int ldk, khs;
    const bf16_t* K2; int ldk2;
    const bf16_t* V; int ldv, vhs;
    bf16_t* O; int ldo, ocol0;
    float sc2;
    const float* cum2_;
    const unsigned* sel_;
    const bf16_t* P;
    const bf16_t* ocmp_; const bf16_t* owin_;
};
template <int MODE, int DK, int HG>
__device__ __forceinline__ void attn_unit(LAS unsigned char* lds, const AttnArgs& A, int b, int kvh, int qb) {
    constexpr int KPB = (DK == 128) ? KP128 : KP192, NKK = DK / 16, QT = 256 / HG;
    constexpr int KS_OFF = 0, VS_OFF = 64 * KPB, CK_OFF = VS_OFF + 64 * VP, STG = CK_OFF + 256, UM_OFF = 2 * STG;
    int tid_op = threadIdx.x; asm volatile("" : "+v"(tid_op));
    const int tid = tid_op, w = __builtin_amdgcn_readfirstlane(tid >> 6), lane = tid & 63, r = lane & 31, hh = lane >> 5;
    const int hd = (HG == 4) ? kvh * 4 + (w & 3) : kvh;
    const int t0 = qb * QT, tw0 = t0 + 32 * (w / HG), t = tw0 + r; const size_t mrow = (size_t)b * T + t; const size_t brow = (size_t)b * T;
    LAS unsigned* ums = (LAS unsigned*)(lds + UM_OFF);
    bf16x8 qf[NKK];
    { const bf16_t* qp = A.Q + mrow * A.ldq + (size_t)hd * A.qhs + 8 * hh;
#pragma unroll
      for (int kk = 0; kk < NKK; ++kk) qf[kk] = *(const bf16x8*)(qp + 16 * kk); }
    float cq = 0.f; unsigned selw = 0xffffffffu; unsigned um = 0xffffffffu;
    if (MODE == 1) cq = A.cum2_[mrow * 8 + hd];
    if (MODE == 3) {
        selw = A.sel_[mrow * 2 + kvh];
        __syncthreads();
        if (w == 0) { unsigned v = A.sel_[(brow + t0 + lane) * 2 + kvh];
#pragma unroll
            for (int o = 1; o < 64; o <<= 1) v |= __shfl_xor(v, o);
            if (lane == 0) ums[0] = v; }
        __syncthreads(); um = ums[0];
    }
    int j0, j1;
    if (MODE == 2) { j0 = t0 / 64 - 8; if (j0 < 0) j0 = 0; j1 = t0 / 64 + 1; } else { j0 = 0; j1 = (t0 + QT) / 64; }
    f32x16 Oa[4];
#pragma unroll
    for (int i = 0; i < 4; ++i)
#pragma unroll
        for (int e = 0; e < 16; ++e) Oa[i][e] = 0.f;
    float mrun = -1e30f, lrun = 0.f;
    u32x4 kreg[3], vreg[2]; float ckreg = 0.f;
#define AT_LOADK(jj) do { const size_t kvrow = brow + (size_t)(jj) * 64; \
        _Pragma("unroll") for (int i = 0; i < 2; ++i) { const int c = tid + 512 * i, row = c >> 4, cc = c & 15; \
            kreg[i] = *(const u32x4*)(A.K + (kvrow + row) * A.ldk + (size_t)kvh * A.khs + 8 * cc); } \
        if (DK == 192) { const int row = tid >> 3, cc = tid & 7; kreg[2] = *(const u32x4*)(A.K2 + (kvrow + row) * A.ldk2 + 8 * cc); } } while (0)
#define AT_LOADV(jj) do { const size_t kvrow = brow + (size_t)(jj) * 64; \
        _Pragma("unroll") for (int i = 0; i < 2; ++i) { const int c = tid + 512 * i, row = c >> 4, cc = c & 15; \
            vreg[i] = *(const u32x4*)(A.V + (kvrow + row) * A.ldv + (size_t)kvh * A.vhs + 8 * cc); } \
        if (MODE == 1) { if (tid < 64) ckreg = A.cum2_[(kvrow + tid) * 8 + hd]; } } while (0)
#define AT_STOREK(sb) do { LAS unsigned char* Ks_ = lds + (sb) * STG + KS_OFF; \
        _Pragma("unroll") for (int i = 0; i < 2; ++i) { const int c = tid + 512 * i, row = c >> 4, cc = c & 15; *(LAS u32x4*)(Ks_ + row * KPB + 16 * cc) = kreg[i]; } \
        if (DK == 192) { const int row = tid >> 3, cc = tid & 7; *(LAS u32x4*)(Ks_ + row * KPB + 256 + 16 * cc) = kreg[2]; } } while (0)
#define AT_STOREV(sb) do { LAS unsigned char* Vs_ = lds + (sb) * STG + VS_OFF; LAS float* cks_ = (LAS float*)(lds + (sb) * STG + CK_OFF); \
        _Pragma("unroll") for (int i = 0; i < 2; ++i) { const int c = tid + 512 * i, row = c >> 4, cc = c & 15; *(LAS u32x4*)(Vs_ + row * VP + 16 * cc) = vreg[i]; } \
        if (MODE == 1) { if (tid < 64) cks_[tid] = ckreg; } } while (0)
#define AT_NEXT(jj, res) do { int q_ = (jj) + 1; if (MODE == 3) { while (q_ < j1 && !((um >> q_) & 1u)) ++q_; } res = q_; } while (0)
#define AT_ACTIVE(jj) (((jj) * 64 <= tw0 + 31) && (MODE != 2 || (jj) * 64 + 63 > tw0 - 512))
    constexpr int FB = (DK == 192) ? 3 : 4, NFB = 2 * NKK / FB;
#define AT_LDF(dst, bi) do { _Pragma("unroll") for (int q_ = 0; q_ < FB; ++q_) { const int f_ = FB * (bi) + q_, kb_ = f_ / NKK, kk_ = f_ % NKK; \
            dst[q_] = *(const LAS bf16x8*)(Ks_ + (32 * kb_ + r) * KPB + (16 * kk_ + 8 * hh) * 2); } } while (0)
#define AT_MMF(src, bi) do { _Pragma("unroll") for (int q_ = 0; q_ < FB; ++q_) { const int f_ = FB * (bi) + q_, kb_ = f_ / NKK, kk_ = f_ % NKK; \
            if (kk_ == 0) S[kb_] = MFMA32(src[q_], qf[kk_], fz_); else S[kb_] = MFMA32(src[q_], qf[kk_], S[kb_]); } } while (0)
#define AT_QK(jj, sb) do { if (AT_ACTIVE(jj)) { LAS unsigned char* Ks_ = lds + (sb) * STG + KS_OFF; \
        f32x16 fz_; _Pragma("unroll") for (int e = 0; e < 16; ++e) fz_[e] = 0.f;     \
        bf16x8 fa_[FB], fb_[FB]; \
        AT_LDF(fa_, 0); __builtin_amdgcn_sched_barrier(0); \
        _Pragma("unroll") for (int bi = 0; bi < NFB; ++bi) { \
            if (bi & 1) { if (bi + 1 < NFB) AT_LDF(fa_, bi + 1); __builtin_amdgcn_sched_barrier(0); AT_MMF(fb_, bi); __builtin_amdgcn_sched_barrier(0); } \
            else        { if (bi + 1 < NFB) AT_LDF(fb_, bi + 1); __builtin_amdgcn_sched_barrier(0); AT_MMF(fa_, bi); __builtin_amdgcn_sched_barrier(0); } } } } while (0)
    const int trq = (lane & 15) >> 2, trp = lane & 3, trb = (lane >> 4) & 1;
    const bool grpB = w >= 4;
    f32x16 S[2]; bf16x8 pf[2][2];
    int jc = j0, jn1, jn2;
    AT_NEXT(jc, jn1); if (jn1 < j1) { AT_NEXT(jn1, jn2); } else jn2 = j1;
    __syncthreads();
    AT_LOADK(jc); AT_LOADV(jc); AT_STOREK(0); AT_STOREV(0);
    if (jn1 < j1) { AT_LOADK(jn1); AT_STOREK(1); }
    if (jn2 < j1) AT_LOADK(jn2);
    if (jn1 < j1) AT_LOADV(jn1);
    __syncthreads();
    AT_QK(jc, 0);
    if (grpB) __syncthreads();
    int n = 0;
    for (;;) {
        const int kv0 = jc * 64;
        const bool active = AT_ACTIVE(jc);
        bool anychg = false; float alpha = 1.f;
        if (active) {
            LAS float* cks = (LAS float*)(lds + (n & 1) * STG + CK_OFF); (void)cks;
            const bool need_mask = (kv0 + 63 > tw0) || (MODE == 2 && kv0 <= tw0 + 31 - 512);
            const bool selok = (MODE != 3) || ((selw >> jc) & 1u);
            float mloc = -1e30f; float muse; float psum = 0.f;
            if (MODE == 1) {
            if (need_mask) {
#pragma unroll
            for (int kb = 0; kb < 2; ++kb)
#pragma unroll
                for (int g4 = 0; g4 < 4; ++g4) {
                    const f32x4 ck4 = *(const LAS f32x4*)(cks + 32 * kb + 8 * g4 + 4 * hh);
#pragma unroll
                    for (int e = 0; e < 4; ++e) { const int key = kv0 + 32 * kb + 8 * g4 + 4 * hh + e;
                        float s2 = S[kb][4 * g4 + e] * A.sc2 + (cq - ck4[e]);
                        s2 = (key <= t) ? s2 : -1e30f; S[kb][4 * g4 + e] = s2; mloc = fmaxf(mloc, s2); }
                }
            } else {
#pragma unroll
            for (int kb = 0; kb < 2; ++kb)
#pragma unroll
                for (int g4 = 0; g4 < 4; ++g4) {
                    const f32x4 ck4 = *(const LAS f32x4*)(cks + 32 * kb + 8 * g4 + 4 * hh);
#pragma unroll
                    for (int e = 0; e < 4; ++e) { const float s2 = S[kb][4 * g4 + e] * A.sc2 + (cq - ck4[e]); S[kb][4 * g4 + e] = s2; mloc = fmaxf(mloc, s2); }
                }
            }
            mloc = fmaxf(mloc, __shfl_xor(mloc, 32));
            const float mnew = fmaxf(mrun, mloc); muse = (mnew < -1e29f) ? 0.f : mnew;
            alpha = fast_exp2(mrun - muse); anychg = __builtin_amdgcn_ballot_w64(mnew > mrun) != 0ull; mrun = mnew;
#pragma unroll
            for (int kb = 0; kb < 2; ++kb)
#pragma unroll
                for (int e = 0; e < 16; ++e) { const float p = fast_exp2(S[kb][e] - muse); S[kb][e] = p; psum += p; }
            } else {
            if (need_mask) {
#pragma unroll
            for (int kb = 0; kb < 2; ++kb)
#pragma unroll
                for (int e = 0; e < 16; ++e) { const int key = kv0 + 32 * kb + (e & 3) + 8 * (e >> 2) + 4 * hh;
                    bool valid = selok && (key <= t); if (MODE == 2) valid = valid && (key > t - 512);
                    const float sr = valid ? S[kb][e] : -3e38f; S[kb][e] = sr; mloc = fmaxf(mloc, sr); }
            } else {
#pragma unroll
            for (int kb = 0; kb < 2; ++kb)
#pragma unroll
                for (int e = 0; e < 16; ++e) { float sr = S[kb][e]; if (MODE == 3) { sr = selok ? sr : -3e38f; S[kb][e] = sr; } mloc = fmaxf(mloc, sr); }
            }
            mloc = fmaxf(mloc, __shfl_xor(mloc, 32)) * A.sc2;
            const float mnew = fmaxf(mrun, mloc); muse = (mnew < -1e29f) ? 0.f : mnew;
            alpha = fast_exp2(mrun - muse); anychg = __builtin_amdgcn_ballot_w64(mnew > mrun) != 0ull; mrun = mnew;
            const float negm = -muse, scv = A.sc2;
#pragma unroll
            for (int kb = 0; kb < 2; ++kb)
#pragma unroll
                for (int e = 0; e < 16; ++e) { float y; asm("v_fma_f32 %0, %1, %2, %3" : "=v"(y) : "v"(S[kb][e]), "s"(scv), "v"(negm)); const float p = fast_exp2(y); S[kb][e] = p; psum += p; }
            }
            lrun = lrun * alpha + psum;
#pragma unroll
            for (int kb = 0; kb < 2; ++kb)
#pragma unroll
                for (int s = 0; s < 2; ++s) { u32x4 pw; pw.x = pk_bf16(S[kb][8 * s], S[kb][8 * s + 1]); pw.y = pk_bf16(S[kb][8 * s + 2], S[kb][8 * s + 3]); pw.z = pk_bf16(S[kb][8 * s + 4], S[kb][8 * s + 5]); pw.w = pk_bf16(S[kb][8 * s + 6], S[kb][8 * s + 7]);
                    pf[kb][s] = __builtin_bit_cast(bf16x8, pw); }
            if (anychg) {
#pragma unroll
            for (int i = 0; i < 4; ++i)
#pragma unroll
                for (int e = 0; e < 16; ++e) Oa[i][e] *= alpha;
            }
        }
        __syncthreads();
        const bool has1 = jn1 < j1;
        if (jn2 < j1) AT_STOREK(n & 1);
        if (has1) AT_STOREV((n + 1) & 1);
        int jn3 = j1; if (jn2 < j1) { AT_NEXT(jn2, jn3); }
        if (jn3 < j1) AT_LOADK(jn3);
        if (jn2 < j1) AT_LOADV(jn2);
        __builtin_amdgcn_s_setprio(1);
        if (active) {
            LAS unsigned char* Vs = lds + (n & 1) * STG + VS_OFF;
            LAS unsigned char* vbase = Vs + (4 * hh + trq) * VP + (16 * trb + 4 * trp) * 2;
            bf16x8 va[4], vb[4];
#define AT_LDV(dst, dvb_) do { _Pragma("unroll") for (int q_ = 0; q_ < 4; ++q_) { LAS unsigned char* vp_ = vbase + (32 * (q_ >> 1) + 16 * (q_ & 1)) * VP + (32 * (dvb_)) * 2; \
                const s16x4 lo_ = tr_read(vp_), hi_ = tr_read(vp_ + 8 * VP); dst[q_] = __builtin_shufflevector(lo_, hi_, 0, 1, 2, 3, 4, 5, 6, 7); } } while (0)
#define AT_MMV(src, dvb_) do { _Pragma("unroll") for (int q_ = 0; q_ < 4; ++q_) Oa[dvb_] = MFMA32(src[q_], pf[q_ >> 1][q_ & 1], Oa[dvb_]); } while (0)
#define SB_ __builtin_amdgcn_sched_barrier(0)
            SB_; AT_LDV(va, 0); SB_; AT_LDV(vb, 1); SB_; AT_MMV(va, 0); SB_; AT_LDV(va, 2); SB_; AT_MMV(vb, 1); SB_; AT_LDV(vb, 3); SB_; AT_MMV(va, 2); SB_; AT_MMV(vb, 3); SB_;
#undef SB_
#undef AT_LDV
#undef AT_MMV
        }
        if (has1) AT_QK(jn1, (n + 1) & 1);
        __builtin_amdgcn_s_setprio(0);
        __syncthreads();
        if (!has1) break;
        jc = jn1; jn1 = jn2; jn2 = jn3; ++n;
    }
    if (!grpB) __syncthreads();
    const float ltot = lrun + __shfl_xor(lrun, 32);
    float inv = ltot > 0.f ? 1.f / ltot : 0.f;
    if (MODE == 2) inv *= sigmoid_f(bf2f(A.P[mrow * HYBN + 5632 + hd * 3 + 2]));
    if (MODE == 3) inv *= sigmoid_f(bf2f(A.P[mrow * HYBN + 5632 + hd * 3 + 1]));
    bf16_t* op = A.O + mrow * A.ldo + A.ocol0 + hd * 128 + 4 * hh;
#pragma unroll
    for (int dvb = 0; dvb < 4; ++dvb)
#pragma unroll
        for (int g4 = 0; g4 < 4; ++g4) {
            float v0 = Oa[dvb][4 * g4] * inv, v1 = Oa[dvb][4 * g4 + 1] * inv, v2 = Oa[dvb][4 * g4 + 2] * inv, v3 = Oa[dvb][4 * g4 + 3] * inv;
            if (MODE == 3) { const size_t o = mrow * 1024 + hd * 128 + 32 * dvb + 8 * g4 + 4 * hh; const u32x2 a = *(const u32x2*)(A.ocmp_ + o), c = *(const u32x2*)(A.owin_ + o);
                v0 += bf_lo(a.x) + bf_lo(c.x); v1 += bf_hi(a.x) + bf_hi(c.x); v2 += bf_lo(a.y) + bf_lo(c.y); v3 += bf_hi(a.y) + bf_hi(c.y); }
            u32x2 o2; o2.x = pk_bf16(v0, v1); o2.y = pk_bf16(v2, v3); *(u32x2*)(op + 32 * dvb + 8 * g4) = o2; }
}
#undef AT_LOADK
#undef AT_LOADV
#undef AT_STOREK
#undef AT_STOREV
#undef AT_NEXT
#undef AT_ACTIVE
#undef AT_QK
#undef AT_LDF
#undef AT_MMF
__device__ __forceinline__ void cmp_unit(LAS unsigned char* lds, const bf16_t* P, const bf16_t* KC, const bf16_t* VC, bf16_t* OCMP, unsigned* SEL, int b, int g, int qb) {
    constexpr int VS_OFF = 128 * KP128, IMP_OFF = VS_OFF + 128 * VP;
    int tid_op = threadIdx.x; asm volatile("" : "+v"(tid_op));
    const int tid = tid_op, w = __builtin_amdgcn_readfirstlane(tid >> 6), lane = tid & 63, r = lane & 31, hh = lane >> 5;
    const int hd = g * 4 + (w & 3), t0 = qb * 64, t = t0 + 32 * (w >> 2) + r; const size_t mrow = (size_t)b * T + t;
    LAS unsigned char* Ks = lds; LAS unsigned char* Vs = lds + VS_OFF; LAS float* IMPW = (LAS float*)(lds + IMP_OFF);
    __syncthreads();
    { const bf16_t* kc = KC + (size_t)(b * 2 + g) * 128 * 128; const bf16_t* vc = VC + (size_t)(b * 2 + g) * 128 * 128;
#pragma unroll
      for (int i = 0; i < 4; ++i) { const int c = tid + 512 * i, row = c >> 4, cc = c & 15;
          *(LAS u32x4*)(Ks + row * KP128 + 16 * cc) = *(const u32x4*)(kc + row * 128 + 8 * cc);
          *(LAS u32x4*)(Vs + row * VP + 16 * cc) = *(const u32x4*)(vc + row * 128 + 8 * cc); } }
    bf16x8 qf[8];
    { const bf16_t* qp = P + mrow * HYBN + hd * 128 + 8 * hh;
#pragma unroll
      for (int kk = 0; kk < 8; ++kk) qf[kk] = *(const bf16x8*)(qp + 16 * kk); }
    __syncthreads();
    f32x16 S[4];
#pragma unroll
    for (int kb = 0; kb < 4; ++kb) {
#pragma unroll
        for (int e = 0; e < 16; ++e) S[kb][e] = 0.f;
#pragma unroll
        for (int kk = 0; kk < 8; ++kk) { const bf16x8 kf = *(const LAS bf16x8*)(Ks + (32 * kb + r) * KP128 + (16 * kk + 8 * hh) * 2); S[kb] = MFMA32(kf, qf[kk], S[kb]); }
    }
    const float sc2 = 0.08838834764831845f * LOG2E;
    float mloc = -1e30f;
#pragma unroll
    for (int kb = 0; kb < 4; ++kb)
#pragma unroll
        for (int e = 0; e < 16; ++e) { const int n = 32 * kb + (e & 3) + 8 * (e >> 2) + 4 * hh; const bool valid = (n < 127) && (16 * n + 31 <= t);
            const float s2 = valid ? S[kb][e] * sc2 : -1e30f; S[kb][e] = s2; mloc = fmaxf(mloc, s2); }
    mloc = fmaxf(mloc, __shfl_xor(mloc, 32));
    const float muse = (mloc < -1e29f) ? 0.f : mloc;
    float psum = 0.f;
#pragma unroll
    for (int kb = 0; kb < 4; ++kb)
#pragma unroll
        for (int e = 0; e < 16; ++e) { const float p = fast_exp2(S[kb][e] - muse); S[kb][e] = p; psum += p; }
    const float ltot = psum + __shfl_xor(psum, 32);
    const float inv = ltot > 0.f ? 1.f / ltot : 0.f;
    {
        float prevrecv = 0.f;
#pragma unroll
        for (int kb = 0; kb < 4; ++kb)
#pragma unroll
            for (int g4 = 0; g4 < 4; ++g4) { const int Gi = 4 * kb + g4;
                const float p0 = S[kb][4 * g4], p1 = S[kb][4 * g4 + 1], p2 = S[kb][4 * g4 + 2], p3 = S[kb][4 * g4 + 3];
                const float ai = ((p0 + p1) + p2 + 0.5f * p3) * inv, bi = 0.5f * p3 * inv;
                const float recv = __shfl_xor(bi, 32);
                const float tot = ai + (hh ? recv : prevrecv); prevrecv = recv;
                IMPW[(w * 32 + r) * 33 + 2 * Gi + hh] = tot; }
    }
    f32x16 Oa[4];
#pragma unroll
    for (int i = 0; i < 4; ++i)
#pragma unroll
        for (int e = 0; e < 16; ++e) Oa[i][e] = 0.f;
    const int trq = (lane & 15) >> 2, trp = lane & 3, trb = (lane >> 4) & 1;
#pragma unroll
    for (int kb = 0; kb < 4; ++kb)
#pragma unroll
        for (int s = 0; s < 2; ++s) { u32x4 pw; pw.x = pk_bf16(S[kb][8 * s], S[kb][8 * s + 1]); pw.y = pk_bf16(S[kb][8 * s + 2], S[kb][8 * s + 3]); pw.z = pk_bf16(S[kb][8 * s + 4], S[kb][8 * s + 5]); pw.w = pk_bf16(S[kb][8 * s + 6], S[kb][8 * s + 7]);
            const bf16x8 pf = __builtin_bit_cast(bf16x8, pw);
#pragma unroll
            for (int dvb = 0; dvb < 4; ++dvb) { LAS unsigned char* vp = Vs + (32 * kb + 16 * s + 4 * hh + trq) * VP + (32 * dvb + 16 * trb + 4 * trp) * 2;
                const s16x4 lo = tr_read(vp), hi = tr_read(vp + 8 * VP);
                const bf16x8 vf = __builtin_shufflevector(lo, hi, 0, 1, 2, 3, 4, 5, 6, 7);
                Oa[dvb] = MFMA32(vf, pf, Oa[dvb]); } }
    const float og = inv * sigmoid_f(bf2f(P[mrow * HYBN + 5632 + hd * 3 + 0]));
    bf16_t* op = OCMP + mrow * 1024 + hd * 128 + 4 * hh;
#pragma unroll
    for (int dvb = 0; dvb < 4; ++dvb)
#pragma unroll
        for (int g4 = 0; g4 < 4; ++g4) { u32x2 o2; o2.x = pk_bf16(Oa[dvb][4 * g4] * og, Oa[dvb][4 * g4 + 1] * og); o2.y = pk_bf16(Oa[dvb][4 * g4 + 2] * og, Oa[dvb][4 * g4 + 3] * og); *(u32x2*)(op + 32 * dvb + 8 * g4) = o2; }
    __syncthreads();
    {
        const int cur = qb, jj = lane & 31, hsel = lane >> 5;
#pragma unroll 1
        for (int it = 0; it < 4; ++it) {
            const int tq = 2 * (w * 4 + it) + hsel, sub = tq >> 5, rr = tq & 31;
            const LAS float* ip = IMPW + ((4 * sub) * 32 + rr) * 33 + jj;
            const float imp = ((ip[0] + ip[32 * 33]) + ip[2 * 32 * 33]) + ip[3 * 32 * 33];
            const bool cand = (jj >= 1) && (jj <= cur - 2);
            const float val = cand ? imp : -1.f;
            int rank = 0;
#pragma unroll
            for (int k = 1; k < 30; ++k) { const float vk = __shfl(val, (lane & 32) | k); rank += ((vk > val) || (vk == val && k < jj)) ? 1 : 0; }
            const bool selb = cand && (rank < 5);
            const unsigned long long bal = __builtin_amdgcn_ballot_w64(selb);
            unsigned mask = (unsigned)(bal >> (32 * hsel));
            if (cur <= 7) mask = (2u << cur) - 1u; else mask |= 1u | (1u << cur) | (1u << (cur - 1));
            if (jj == 0) SEL[((size_t)b * T + t0 + tq) * 2 + g] = mask;
        }
    }
}
__device__ __forceinline__ int fetch_unit_x(unsigned* ctr8, int xcd, int per, LAS int* slot) {
    __syncthreads();
    if (threadIdx.x == 0) { int res = -1;
        for (int k = 0; k < 8; ++k) { const int x = (xcd + k) & 7; if (__hip_atomic_load(ctr8 + 64 * x, __ATOMIC_RELAXED, __HIP_MEMORY_SCOPE_AGENT) >= (unsigned)per) continue;
            const unsigned v = atomicAdd(ctr8 + 64 * x, 1u); if (v < (unsigned)per) { res = x * per + (int)v; break; } }
        *slot = res; }
    __syncthreads();
    return *slot;
}
__global__ void __launch_bounds__(512, 2) mega_fwd(Args a) {
    extern __shared__ __attribute__((aligned(16))) unsigned char lds_raw[];
    LAS unsigned char* lds = (LAS unsigned char*)lds_raw;
    LAS int* slot = (LAS int*)(lds + MISC_OFF);
    cg::grid_group grid = cg::this_grid();
    const int tid = threadIdx.x, lane = tid & 63, wave = tid >> 6, G = gridDim.x, bid = blockIdx.x;
    const int gw = bid * 8 + wave, NGW = G * 8, gtid = bid * 512 + tid, NGT = G * 512;
    unsigned char* ws = a.ws;
    unsigned* ctl = (unsigned*)(ws + WS_CTL);
#define SSQ ((float*)(a.ws + WS_SSQ))
#define SSQ2 ((float*)(a.ws + WS_SSQ2))
#define CUM2 ((float*)(a.ws + WS_CUM))
#define SEL ((unsigned*)(a.ws + WS_SEL))
#define BPART ((float*)(a.ws + WS_BPART))
#define BIASPE ((float*)(a.ws + WS_BIASPE))
#define ROPE128 ((float*)(a.ws + WS_ROPE128))
#define ROPE64 ((float*)(a.ws + WS_ROPE64))
#define HID ((bf16_t*)(a.ws + WS_HID))
#define KCVC ((bf16_t*)(a.ws + WS_KCVC))
#define HYBIN ((bf16_t*)(a.ws + WS_HYBIN))
#define HYBOUT ((bf16_t*)(a.ws + WS_HYBOUT))
#define MLAIN ((bf16_t*)(a.ws + WS_MLAIN))
#define UQKV ((bf16_t*)(a.ws + WS_UQKV))
#define MLAOUT ((bf16_t*)(a.ws + WS_MLAOUT))
#define CMPW1 ((bf16_t*)(a.ws + WS_CMPW1))
#define XB ((bf16_t*)(a.ws + WS_XB))
#define ACT ((bf16_t*)(a.ws + WS_ACT))
#define OBUF ((bf16_t*)(a.ws + WS_OBUF))
#define PBUF ((bf16_t*)(a.ws + WS_PBUF))
#define QR ((bf16_t*)(a.ws + WS_QR))
#define CMPIN ((bf16_t*)(a.ws + WS_CMPIN))
#define OWIN ((bf16_t*)(a.ws + WS_OWIN))
#define OCMP ((bf16_t*)(a.ws + WS_OCMP))
#define CB ((bf16_t*)(a.ws + WS_C))
#define QBUF ((bf16_t*)(a.ws + WS_QBUF))
#define KVBUF ((bf16_t*)(a.ws + WS_KVBUF))
    float* X = a.out;

    if (PROBE_TSMASK) { if (blockIdx.x == 0 && threadIdx.x == 0) ((unsigned long long*)(a.ws + 65536))[23] = __builtin_amdgcn_s_memrealtime(); }
    if (tid < 2) ((volatile LAS unsigned*)(lds + MISC_OFF + 32))[tid] = 0u;
    if (a.ws == nullptr) grid.sync();
    __syncthreads();
    XcdBarrier xbar = xcd_barrier_post(ctl + 4096, (volatile LAS unsigned*)(lds + MISC_OFF + 32));
    int ts_idx = 0; (void)ts_idx;
    if (PROBE_TSMASK) { if (bid == 0 && tid == 0) ((unsigned long long*)(a.ws + 65536))[0] = __builtin_amdgcn_s_memrealtime(); }
#pragma unroll 1
    for (int rep = 0; rep < 1 + PROBE_P0X2; ++rep) {
    {
        LAS float* scr = (LAS float*)(lds + wave * 16384);
#define TJOBX(MODE, W, K, N, NP, gain, dst, gw_, ngw_) for (int it = (gw_); it < ((K) / 64) * ((NP) / 32); it += (ngw_)) transpose_item<MODE>(W, K, N, NP, gain, dst, scr, it, lane)
#define TJOBQ(MODE, W, K, N, NP, gain, dst, ctr, it0, it1) do { int tid_q = threadIdx.x; asm volatile("" : "+v"(tid_q)); const int lane = tid_q & 63, wave = __builtin_amdgcn_readfirstlane(tid_q >> 6); \
        LAS float* scr = (LAS float*)(lds + wave * 16384); \
        for (;;) { __syncthreads(); if (tid_q == 0) *slot = (it0) + (int)atomicAdd((ctr), 8u); __syncthreads(); const int base_ = *slot; if (base_ >= (it1)) break; \
            if (base_ + wave < (it1)) transpose_item<MODE>(W, K, N, NP, gain, dst, scr, base_ + wave, lane); } } while (0)
#define TJOBR(MODE, W, K, N, NP, gain, dst, gw_, ngw_, it0, it1) for (int it = (it0) + (gw_); it < (it1); it += (ngw_)) transpose_item<MODE>(W, K, N, NP, gain, dst, scr, it, lane)
        TJOBX(1, a.in[2], 2048, 11264, 11264, a.in[1], (bf16_t*)(ws + WS_W1T), gw, NGW);
        TJOBX(0, a.in[3], 5632, 2048, 2048, (const float*)nullptr, (bf16_t*)(ws + WS_W2T), gw, NGW);
        TJOBR(1, a.in[6] + (size_t)2048 * 11264, 2048, 11264, 11264, a.in[5] + 2048, (bf16_t*)(ws + WS_W1T + (size_t)3 * 44 * MiB), gw, NGW, 9088, 11264);
    }
    for (int m = gw; m < M; m += NGW) {
        const f32x4* xr = (const f32x4*)(a.in[0] + (size_t)m * D) + lane; u32x2* xo = (u32x2*)(XB + (size_t)m * D) + lane; float s = 0.f;
#pragma unroll
        for (int j = 0; j < 8; ++j) { const f32x4 v = xr[64 * j]; s += (v[0] * v[0] + v[1] * v[1]) + (v[2] * v[2] + v[3] * v[3]); u32x2 o; o.x = pk_bf16(v[0], v[1]); o.y = pk_bf16(v[2], v[3]); xo[64 * j] = o; }
        s = wave_sum(s);
        if (lane < 32) SSQ[(size_t)m * 32 + lane] = lane == 0 ? s : 0.f;
    }
    for (int i = gtid; i < 2048 * 64; i += NGT) { const int t = i >> 6, ii = i & 63; const float e = (float)(2 * ii) / 128.f; const float pw = (float)pow(10000.0, (double)e); const float inv = 1.0f / pw; const float ang = (float)t * inv;
        ROPE128[2 * i] = cosf(ang); ROPE128[2 * i + 1] = sinf(ang); }
    for (int i = gtid; i < 2048 * 32; i += NGT) { const int t = i >> 5, ii = i & 31; const float e = (float)(2 * ii) / 64.f; const float pw = (float)pow(10000.0, (double)e); const float inv = 1.0f / pw; const float ang = (float)t * inv;
        ROPE64[2 * i] = cosf(ang); ROPE64[2 * i + 1] = sinf(ang); }
    if (bid < 64) { const int kv = tid >> 8, c = tid & 255; const float* pe = a.in[10] + kv * 4096 + bid * 64; const float* w1 = a.in[11] + (size_t)kv * 4096 * 256 + (size_t)bid * 64 * 256 + c; float s = 0.f;
#pragma unroll 8
        for (int k = 0; k < 64; ++k) s += pe[k] * w1[(size_t)k * 256];
        BPART[bid * 512 + tid] = s; }
    }
    GSYNC();

#pragma unroll 1
    for (int k = 0; k < 4; ++k) {
#pragma unroll 1
        for (int rep = 0; rep < 1 + PROBE_UPX2; ++rep) {
            pg8::Gemm g{XB, XB, (const bf16_t*)(ws + WS_W1T + (size_t)k * 44 * MiB), M, 11264, 2048, 2048, 1 << 30};
            pg8::StaticOrder S; S.init(M, 11264, G, bid);
            pg8::EpiSwiglu E{ACT, DFF, SSQ};
            pg8::gemm_phase<pg8::EpiSwiglu, pg8::StaticOrder, true, true>(lds, g, S, E);
        }
        if (bid >= G / 2) {
            int tid_o = threadIdx.x; asm volatile("" : "+v"(tid_o)); const int lane = tid_o & 63, wave = __builtin_amdgcn_readfirstlane(tid_o >> 6);
            LAS float* scr = (LAS float*)(lds + wave * 16384);
            const int tgw = (bid - G / 2) * 8 + wave, TNG = (G - G / 2) * 8;
            if (k == 0) {
                TJOBX(2, a.in[8], 2048, 5664, 5888, a.in[4], HYBIN, tgw, TNG);
                TJOBX(0, a.in[9], 2048, 2048, 2048, (const float*)nullptr, HYBOUT, tgw, TNG);
                TJOBX(0, a.in[11], 4096, 256, 256, (const float*)nullptr, CMPW1, tgw, TNG);
                TJOBX(0, a.in[11] + (size_t)4096 * 256, 4096, 256, 256, (const float*)nullptr, CMPW1 + (size_t)256 * 4096, tgw, TNG);
                TJOBR(1, a.in[6], 2048, 11264, 11264, a.in[5], (bf16_t*)(ws + WS_W1T + (size_t)1 * 44 * MiB), tgw, TNG, 0, 3680);
            } else if (k == 1) {
                TJOBX(0, a.in[7], 5632, 2048, 2048, (const float*)nullptr, (bf16_t*)(ws + WS_W2T + (size_t)1 * 22 * MiB), tgw, TNG);
                TJOBR(1, a.in[2] + (size_t)2048 * 11264, 2048, 11264, 11264, a.in[1] + 2048, (bf16_t*)(ws + WS_W1T + (size_t)2 * 44 * MiB), tgw, TNG, 0, 6656);
            } else if (k == 2) {
                TJOBX(0, a.in[3] + (size_t)5632 * 2048, 5632, 2048, 2048, (const float*)nullptr, (bf16_t*)(ws + WS_W2T + (size_t)2 * 22 * MiB), tgw, TNG);
                TJOBX(4, a.in[14], 2048, 1088, 1280, a.in[4] + 2048, MLAIN, tgw, TNG);
                TJOBX(3, a.in[17], 512, 3072, 3072, a.in[15], UQKV, tgw, TNG);
                TJOBX(0, a.in[18], 512, 4096, 4096, a.in[16], UQKV + (size_t)3072 * 512, tgw, TNG);
                TJOBX(0, a.in[19], 2048, 2048, 2048, (const float*)nullptr, MLAOUT, tgw, TNG);
                TJOBR(1, a.in[6] + (size_t)2048 * 11264, 2048, 11264, 11264, a.in[5] + 2048, (bf16_t*)(ws + WS_W1T + (size_t)3 * 44 * MiB), tgw, TNG, 0, 1728);
            } else {
                TJOBX(0, a.in[7] + (size_t)5632 * 2048, 5632, 2048, 2048, (const float*)nullptr, (bf16_t*)(ws + WS_W2T + (size_t)3 * 22 * MiB), tgw, TNG);
            }
        }
        GSYNC();
        {
            pg8::Gemm g{ACT, ACT, (const bf16_t*)(ws + WS_W2T + (size_t)k * 22 * MiB), M, 2048, DFF, DFF, 1 << 30};
            pg8::StaticOrder S; S.init(M, 2048, G, bid);
            pg8::EpiResid E{k == 0 ? a.in[0] : X, X, XB, SSQ, 0.5f};
            pg8::gemm_phase<pg8::EpiResid, pg8::StaticOrder, true, true>(lds, g, S, E);
        }
        GSYNC();
        if (k == 0) {
            {
                pg8::Gemm g{XB, XB, HYBIN, M, HYBN, 2048, 2048, 1 << 30};
                pg8::StaticOrder S; S.init(M, HYBN, G, bid);
                pg8::EpiScale<8, false> E{PBUF, HYBN, PBUF, HYBN, 1 << 30, SSQ, 0, 0, 1.f / 2048.f, nullptr, nullptr};
                pg8::gemm_phase<pg8::EpiScale<8, false>, pg8::StaticOrder, true, true>(lds, g, S, E);
            }
            if (bid >= 224 && G == 256) {
                int tid_o = threadIdx.x; asm volatile("" : "+v"(tid_o)); const int lane = tid_o & 63, wave = __builtin_amdgcn_readfirstlane(tid_o >> 6);
                LAS float* scr = (LAS float*)(lds + wave * 16384);
                TJOBR(1, a.in[6], 2048, 11264, 11264, a.in[5], (bf16_t*)(ws + WS_W1T + (size_t)1 * 44 * MiB), (bid - 224) * 8 + wave, 32 * 8, 3680, 6752);
            } else if (G != 256) {
                int tid_o = threadIdx.x; asm volatile("" : "+v"(tid_o)); const int lane = tid_o & 63, wave = __builtin_amdgcn_readfirstlane(tid_o >> 6);
                LAS float* scr = (LAS float*)(lds + wave * 16384);
                TJOBR(1, a.in[6], 2048, 11264, 11264, a.in[5], (bf16_t*)(ws + WS_W1T + (size_t)1 * 44 * MiB), bid * 8 + wave, G * 8, 3680, 6752);
            }
            GSYNC();
            {
                int tid_o = threadIdx.x; asm volatile("" : "+v"(tid_o)); const int tid = tid_o, lane = tid & 63, wave = __builtin_amdgcn_readfirstlane(tid >> 6), gw = bid * 8 + wave, gtid = bid * 512 + tid; (void)lane; (void)gw; (void)gtid;
                const bool ded = true; const int g2 = gtid - 8192, N2 = NGT - 8192;
                if (gw >= 128) {
                for (int i0 = g2; i0 < M * 12 * 8; i0 += 2 * N2) {
                    u32x4 x1[2], x2[2]; f32x4 cs[2][4]; bf16_t* dstp[2]; bool ok[2];
#pragma unroll
                    for (int e = 0; e < 2; ++e) {
                        const int i = i0 + e * N2; ok[e] = i < M * 12 * 8; const int ii = ok[e] ? i : i0;
                        const int c8 = ii & 7, u = (ii >> 3) % 12, m = ii / 96, t = m & (T - 1);
                        const bf16_t* src; bf16_t* dst;
                        if (u < 8) { src = PBUF + (size_t)m * HYBN + u * 128; dst = QR + (size_t)m * 1024 + u * 128; }
                        else if (u < 10) { src = PBUF + (size_t)m * HYBN + 1536 + (u - 8) * 128; dst = (bf16_t*)src; }
                        else { src = PBUF + (size_t)m * HYBN + 2048 + (u - 10) * 128; dst = (bf16_t*)src; }
                        x1[e] = *(const u32x4*)(src + 8 * c8); x2[e] = *(const u32x4*)(src + 64 + 8 * c8);
                        const f32x4* csp = (const f32x4*)(ROPE128 + ((size_t)t * 64 + 8 * c8) * 2);
#pragma unroll
                        for (int q = 0; q < 4; ++q) cs[e][q] = csp[q];
                        dstp[e] = dst + 8 * c8;
                    }
#pragma unroll
                    for (int e = 0; e < 2; ++e) { u32x4 o1, o2;
#pragma unroll
                        for (int q = 0; q < 4; ++q) { const f32x4 c = cs[e][q]; const float a0 = bf_lo(x1[e][q]), a1 = bf_hi(x1[e][q]), b0 = bf_lo(x2[e][q]), b1 = bf_hi(x2[e][q]);
                            o1[q] = pk_bf16(a0 * c[0] - b0 * c[1], a1 * c[2] - b1 * c[3]); o2[q] = pk_bf16(b0 * c[0] + a0 * c[1], b1 * c[2] + a1 * c[3]); }
                        if (ok[e]) { *(u32x4*)(dstp[e]) = o1; *(u32x4*)(dstp[e] + 64) = o2; } }
                }
                for (int i = g2; i < M * 4 * 16; i += N2) {
                    const int cc = i & 15, gg = (i >> 4) & 1, kv = (i >> 5) & 1, m = i >> 6, b = m >> 11, t = m & (T - 1);
                    *(u32x4*)(CMPIN + ((size_t)kv * 8 + b * 2 + gg) * T * 128 + (size_t)t * 128 + 8 * cc) = *(const u32x4*)(PBUF + (size_t)m * HYBN + 1024 + kv * 256 + gg * 128 + 8 * cc);
                }
                }
                if (gw < 128) {
                    const int seq = bid * 2 + (wave >> 2), wq = wave & 3, b = seq >> 3, h = seq & 7; const float fb = a.in[13][h]; float v[8]; float s = 0.f;
                    const size_t tb = (size_t)b * T + wq * 512 + lane * 8;
#pragma unroll
                    for (int i = 0; i < 8; ++i) { const float z = bf2f(PBUF[(tb + i) * HYBN + 5656 + h]) + fb; const float lf = fminf(z, 0.f) - log1pf(__expf(-fabsf(z))); s += lf; v[i] = s; }
                    float incl = s;
#pragma unroll
                    for (int o = 1; o < 64; o <<= 1) { const float n = __shfl_up(incl, o); if (lane >= o) incl += n; }
                    LAS float* tot = (LAS float*)(lds + MISC_OFF + 64);
                    if (lane == 63) tot[wave] = incl;
                    __syncthreads();
                    float offs = 0.f;
#pragma unroll
                    for (int q = 0; q < 3; ++q) if (q < wq) offs += tot[(wave & 4) + q];
                    const float excl = offs + (incl - s);
#pragma unroll
                    for (int i = 0; i < 8; ++i) CUM2[(tb + i) * 8 + h] = (excl + v[i]) * LOG2E;
                }
                if (gw >= 128 && gw < 128 + 512) { const int o = gw - 128; const float s = wave_sum(BPART[lane * 512 + o]); if (lane == 0) BIASPE[o] = s; }
            }
            GSYNC();
            {
                pg8::Gemm g{CMPIN, CMPIN + (size_t)8 * T * 128, CMPW1, 1024, 512, 4096, 2048, 1};
                pg8::ListOrder S; S.init(1024, 512, G, bid);
                pg8::EpiGelu E{HID, BIASPE};
                pg8::gemm_phase<pg8::EpiGelu, pg8::ListOrder, true, true>(lds, g, S, E);
                AttnArgs af{}; af.Q = PBUF + 2560; af.ldq = HYBN; af.qhs = 128; af.K = PBUF + 3584; af.ldk = HYBN; af.khs = 128; af.K2 = nullptr; af.ldk2 = 0; af.V = PBUF + 4608; af.ldv = HYBN; af.vhs = 128;
                af.O = OBUF; af.ldo = 2048; af.ocol0 = 1024; af.sc2 = 0.08838834764831845f * LOG2E; af.cum2_ = CUM2; af.sel_ = SEL; af.P = PBUF; af.ocmp_ = OCMP; af.owin_ = OWIN;
                AttnArgs aw = af; aw.Q = QR; aw.ldq = 1024; aw.K = PBUF + 2048; aw.V = PBUF + 2304; aw.O = OWIN; aw.ldo = 1024; aw.ocol0 = 0;
                for (int arep = 0; arep < 1 + PROBE_ATTX2; ++arep) for (;;) {
                    const int u = fetch_unit_x(ctl + 64 * 8 * (1 + 4 * arep), (int)xbar.x & 7, 64, slot);
                    if (u < 0) break;
                    const int x = u >> 6, v = u & 63;
                    if (v < 32) { const int qb = 7 - (v >> 2), bh = x + 8 * (v & 3); attn_unit<1, 128, 1>(lds, af, bh >> 3, bh & 7, qb); }
                    else { const int qb = 63 - v, bg = x; attn_unit<2, 128, 4>(lds, aw, bg >> 1, bg & 1, qb); }
                }
                TJOBQ(1, a.in[6], 2048, 11264, 11264, a.in[5], (bf16_t*)(ws + WS_W1T + (size_t)1 * 44 * MiB), ctl + 64 * 40, 6752, 11264);
            }
            GSYNC();
            {
                int tid_o = threadIdx.x; asm volatile("" : "+v"(tid_o)); const int tid = tid_o, lane = tid & 63, wave = __builtin_amdgcn_readfirstlane(tid >> 6), gw = bid * 8 + wave, gtid = bid * 512 + tid; (void)lane; (void)gw; (void)gtid;
                for (int i = gtid; i < 2 * 256 * 128 * 2; i += NGT) {
                    const int ch = i & 1, d = (i >> 1) & 127, rg = (i >> 8) & 255, kv = i >> 16;
                    const bf16_t* hp = HID + ((size_t)kv * 1024 + 4 * rg) * 256 + 128 * ch; const float* wp = a.in[12] + (size_t)kv * 256 * 128 + (size_t)(128 * ch) * 128 + d;
                    float s0 = 0.f, s1 = 0.f, s2 = 0.f, s3 = 0.f;
#pragma unroll 4
                    for (int c8 = 0; c8 < 16; ++c8) {
                        const u32x4 h0 = *(const u32x4*)(hp + 8 * c8), h1 = *(const u32x4*)(hp + 256 + 8 * c8), h2 = *(const u32x4*)(hp + 512 + 8 * c8), h3 = *(const u32x4*)(hp + 768 + 8 * c8);
#pragma unroll
                        for (int q = 0; q < 4; ++q) { const float w0 = wp[(size_t)(8 * c8 + 2 * q) * 128], w1 = wp[(size_t)(8 * c8 + 2 * q + 1) * 128];
                            s0 += bf_lo(h0[q]) * w0 + bf_hi(h0[q]) * w1; s1 += bf_lo(h1[q]) * w0 + bf_hi(h1[q]) * w1; s2 += bf_lo(h2[q]) * w0 + bf_hi(h2[q]) * w1; s3 += bf_lo(h3[q]) * w0 + bf_hi(h3[q]) * w1; }
                    }
                    s0 += __shfl_xor(s0, 1); s1 += __shfl_xor(s1, 1); s2 += __shfl_xor(s2, 1); s3 += __shfl_xor(s3, 1);
                    if (ch == 0) { bf16_t* kp = KCVC + ((size_t)kv * 1024 + 4 * rg) * 128 + d;
                        if ((rg & 31) == 31) s3 = 0.f;
                        kp[0] = (bf16_t)(pk_bf16(s0, 0.f) & 0xffffu); kp[128] = (bf16_t)(pk_bf16(s1, 0.f) & 0xffffu); kp[256] = (bf16_t)(pk_bf16(s2, 0.f) & 0xffffu); kp[384] = (bf16_t)(pk_bf16(s3, 0.f) & 0xffffu); }
                }
            }
            GSYNC();
            {
                for (int arep = 0; arep < 1 + PROBE_ATTX2; ++arep) for (;;) {
                    const int u = fetch_unit_x(ctl + 64 * 8 * (2 + 4 * arep), (int)xbar.x & 7, 32, slot);
                    if (u < 0) break;
                    const int qb = 31 - (u & 31), bg = u >> 5;
                    cmp_unit(lds, PBUF, KCVC, KCVC + (size_t)1024 * 128, OCMP, SEL, bg >> 1, bg & 1, qb);
                }
            }
            GSYNC();
            {
                AttnArgs as{}; as.Q = QR; as.ldq = 1024; as.qhs = 128; as.K = PBUF + 1536; as.ldk = HYBN; as.khs = 128; as.K2 = nullptr; as.ldk2 = 0; as.V = PBUF + 1792; as.ldv = HYBN; as.vhs = 128;
                as.O = OBUF; as.ldo = 2048; as.ocol0 = 0; as.sc2 = 0.08838834764831845f * LOG2E; as.cum2_ = CUM2; as.sel_ = SEL; as.P = PBUF; as.ocmp_ = OCMP; as.owin_ = OWIN;
                for (int arep = 0; arep < 1 + PROBE_ATTX2; ++arep) for (;;) {
                    const int u = fetch_unit_x(ctl + 64 * 8 * (3 + 4 * arep), (int)xbar.x & 7, 32, slot);
                    if (u < 0) break;
                    const int qb = 31 - (u & 31), bg = u >> 5;
                    attn_unit<3, 128, 4>(lds, as, bg >> 1, bg & 1, qb);
                }
                TJOBQ(1, a.in[2] + (size_t)2048 * 11264, 2048, 11264, 11264, a.in[1] + 2048, (bf16_t*)(ws + WS_W1T + (size_t)2 * 44 * MiB), ctl + 64 * 41, 6656, 11264);
            }
            GSYNC();
        }
        if (k == 2) {
            {
                pg8::Gemm g{XB, XB, MLAIN, M, MLAN, 2048, 2048, 1 << 30};
                pg8::StaticOrder S; S.init(M, MLAN, G, bid);
                pg8::EpiScale<8, true, 2> E{CB, MLAN, CB, MLAN, 1 << 30, SSQ, 0, 0, 1.f / 2048.f, SSQ2, ROPE64};
                pg8::gemm_phase<pg8::EpiScale<8, true, 2>, pg8::StaticOrder, true, true>(lds, g, S, E);
            }
            if (bid >= 160 && G == 256) {
                int tid_o = threadIdx.x; asm volatile("" : "+v"(tid_o)); const int lane = tid_o & 63, wave = __builtin_amdgcn_readfirstlane(tid_o >> 6);
                LAS float* scr = (LAS float*)(lds + wave * 16384);
                TJOBR(1, a.in[6] + (size_t)2048 * 11264, 2048, 11264, 11264, a.in[5] + 2048, (bf16_t*)(ws + WS_W1T + (size_t)3 * 44 * MiB), (bid - 160) * 8 + wave, 96 * 8, 1728, 9088);
            } else if (G != 256) {
                int tid_o = threadIdx.x; asm volatile("" : "+v"(tid_o)); const int lane = tid_o & 63, wave = __builtin_amdgcn_readfirstlane(tid_o >> 6);
                LAS float* scr = (LAS float*)(lds + wave * 16384);
                TJOBR(1, a.in[6] + (size_t)2048 * 11264, 2048, 11264, 11264, a.in[5] + 2048, (bf16_t*)(ws + WS_W1T + (size_t)3 * 44 * MiB), bid * 8 + wave, G * 8, 1728, 9088);
            }
            GSYNC();
            {
                pg8::Gemm g{CB, CB + 512, UQKV, M, 7168, 512, MLAN, 12};
                pg8::StaticOrder S; S.init(M, 7168, G, bid);
                pg8::EpiScale<2, false, 1> E{QBUF, 3072, KVBUF, 4096, 12, SSQ2, 0, 8, 1.f / 512.f, nullptr, ROPE64};
                pg8::gemm_phase<pg8::EpiScale<2, false, 1>, pg8::StaticOrder, true, true>(lds, g, S, E);
            }
            GSYNC();
            {
                AttnArgs am{}; am.Q = QBUF; am.ldq = 3072; am.qhs = 192; am.K = KVBUF; am.ldk = 4096; am.khs = 256; am.K2 = CB + 1024; am.ldk2 = MLAN; am.V = KVBUF + 128; am.ldv = 4096; am.vhs = 256;
                am.O = OBUF; am.ldo = 2048; am.ocol0 = 0; am.sc2 = 0.07216878364870322f * LOG2E; am.cum2_ = CUM2; am.sel_ = SEL; am.P = PBUF; am.ocmp_ = OCMP; am.owin_ = OWIN;
                for (int arep = 0; arep < 1 + PROBE_ATTX2; ++arep) for (;;) {
                    const int u = fetch_unit_x(ctl + 64 * 8 * (4 + 4 * arep), (int)xbar.x & 7, 64, slot);
                    if (u < 0) break;
                    const int x = u >> 6, v = u & 63; const int qb = 7 - (v >> 3), bh = x + 8 * (v & 7);
                    attn_unit<0, 192, 1>(lds, am, bh >> 4, bh & 15, qb);
                }
            }
            GSYNC();
        }
        if (k == 0 || k == 2) {
            pg8::Gemm g{OBUF, OBUF, k == 0 ? HYBOUT : MLAOUT, M, 2048, 2048, 2048, 1 << 30};
            pg8::StaticOrder S; S.init(M, 2048, G, bid);
            pg8::EpiResid E{X, X, XB, SSQ, 1.0f};
            pg8::gemm_phase<pg8::EpiResid, pg8::StaticOrder, true, true>(lds, g, S, E);
            GSYNC();
        }
    }
    {
                int tid_o = threadIdx.x; asm volatile("" : "+v"(tid_o)); const int tid = tid_o, lane = tid & 63, wave = __builtin_amdgcn_readfirstlane(tid >> 6), gw = bid * 8 + wave, gtid = bid * 512 + tid; (void)lane; (void)gw; (void)gtid;
    for (int m = gw; m < M; m += NGW) {
        float s = (lane < 32) ? SSQ[(size_t)m * 32 + lane] : 0.f; s = wave_sum(s);
        const float rs = rsqrtf(s * (1.f / 2048.f) + pg8::NORM_EPS);
        f32x4* xr = (f32x4*)(X + (size_t)m * D) + lane; const f32x4* gr = (const f32x4*)a.in[20] + lane;
#pragma unroll
        for (int j = 0; j < 8; ++j) { f32x4 v = xr[64 * j]; const f32x4 g4 = gr[64 * j]; v = v * rs * g4; xr[64 * j] = v; }
    }
    }    if (PROBE_TSMASK) {
        GSYNC();
        __threadfence(); __syncthreads();
        if (bid == 0) {
            const unsigned long long* ts = (const unsigned long long*)(a.ws + 65536); unsigned long long tot = 0;
            for (int n = 1; n <= 22; ++n) if ((PROBE_TSMASK >> n) & 1u) tot += ts[n] - ts[n - 1];
            if ((PROBE_TSMASK >> 23) & 1u) tot += ts[0] - ts[23];
            const float code = (float)tot * 10.0f;
            const float delta = sqrtf(code * 1.0246e-8f);
            for (int i = threadIdx.x; i < 16384; i += 512) X[i] += delta;
        }
    }
}

extern "C" void kernel_launch(void* const* d_in, const int* in_sizes, int n_in, void* d_out, int out_size, void* d_ws, size_t ws_size, hipStream_t stream) {
    static int grid = 0;
    if (grid == 0) {
        if (n_in != 21 || ws_size < WS_END) { fprintf(stderr, "kernel_launch: unexpected n_in %d or ws %zu (< %zu)\n", n_in, ws_size, (size_t)WS_END); grid = -1; return; }
        int dev = 0, cus = 0, per_cu = 0;
        hipGetDevice(&dev); hipDeviceGetAttribute(&cus, hipDeviceAttributeMultiprocessorCount, dev);
        if (hipFuncSetAttribute((const void*)mega_fwd, hipFuncAttributeMaxDynamicSharedMemorySize, LDS_BYTES) != hipSuccess) { fprintf(stderr, "hipFuncSetAttribute failed\n"); grid = -1; return; }
        if (hipOccupancyMaxActiveBlocksPerMultiprocessor(&per_cu, (const void*)mega_fwd, 512, LDS_BYTES) != hipSuccess || per_cu < 1) { fprintf(stderr, "occupancy query: %d\n", per_cu); per_cu = 1; }
        (void)hipGetLastError();
        grid = cus * 1;
    }
    if (grid < 0) return;
    if (hipMemsetAsync(d_ws, 0, 65536, stream) != hipSuccess) { fprintf(stderr, "memset of control words failed\n"); return; }
    Args a{};
    for (int i = 0; i < 21; ++i) a.in[i] = (const float*)d_in[i];
    a.out = (float*)d_out; a.ws = (unsigned char*)d_ws;
    void* args[] = {&a};
    hipError_t e = hipLaunchCooperativeKernel((const void*)mega_fwd, dim3(grid), dim3(512), args, LDS_BYTES, stream);
    if (e != hipSuccess) fprintf(stderr, "cooperative launch failed: %s (grid %d)\n", hipGetErrorString(e), grid);
}
```
